# Optimizing an MI355X kernel written in HIP

```python
import math
import jax, jax.numpy as jnp
from jax import lax
import numpy as np

D_MODEL = 1024
BATCH = 32
SEQ = 256
DEPTH = 2
DEC_BATCH = 8
DEC_SEQ = 4096
PAST_LEN = 256

GRID_W = 64
HEAD_DIM = 64
MIX_A = D_MODEL // 4
MIX_B = D_MODEL // 4
MIX_C = D_MODEL // 4
MIX_D = D_MODEL // 4
MIX_WIDTH = MIX_A + MIX_B + MIX_C + MIX_D
RW_HEADS = MIX_A // HEAD_DIM
RW_DECAY_LORA = 64
RW_A_LORA = 64
RW_GATE_LORA = 128
RW_COLS = 3 * MIX_A + RW_DECAY_LORA + RW_A_LORA + RW_GATE_LORA
RW_EPS = 64e-5
S5_CH = 16
S5_GROUPS = MIX_B // S5_CH
S5_STATE = 64
HG_HEADS = MIX_C // HEAD_DIM
HG_CHUNK = 64
NA_HEADS = MIX_D // HEAD_DIM
NA_ROWS = 8
NA_COLS = 16
Q_BLOCK = 128
D_FF = 128 * ((8 * D_MODEL // 3 + 127) // 128)
N_MOD = 9
IN_COLS = RW_COLS + MIX_B + 5 * MIX_C + 3 * MIX_D
ALPHA = (2 * DEPTH) ** 0.25
BETA = (8 * DEPTH) ** -0.25
LN_EPS = 1e-5
F_TINY = 1e-30

kernel_name = 'hybrid_flow_trunk_step'


def _split(p, sizes):
    idx = np.cumsum(sizes)[:-1].tolist()
    return jnp.split(p, idx, axis=-1)


def _norm_last(y, eps):
    yf = y.astype(jnp.float32)
    mu = jnp.mean(yf, -1, keepdims=True)
    var = jnp.mean(jnp.square(yf - mu), -1, keepdims=True)
    return (yf - mu) * lax.rsqrt(var + eps)


def layer_norm(x, g, b):
    return (_norm_last(x, LN_EPS) * g + b).astype(x.dtype)


def modulate(x, shift, scale):
    return x * (1 + scale) + shift


def swiglu(h, w_in, w_out):
    gate, up = jnp.split(h @ w_in, 2, axis=-1)
    return (jax.nn.silu(gate) * up) @ w_out


def token_shift(p, mu_prev, mu_next):
    prev = jnp.pad(p[:, :-1], ((0, 0), (1, 0), (0, 0)))
    nxt = jnp.pad(p[:, 1:], ((0, 0), (0, 1), (0, 0)))
    return p + mu_prev * (prev - p) + mu_next * (nxt - p)


def rwkv7_scan(r, w, k, v, kk, kka, s0, reverse):
    xs = tuple(jnp.moveaxis(t, 1, 0) for t in (r, w, k, v, kk, kka))

    def step(S, inp):
        r_t, w_t, k_t, v_t, kk_t, b_t = inp
        sa = -jnp.einsum('bhvk,bhk->bhv', S, kk_t)
        S = S * w_t[:, :, None, :] + sa[..., None] * b_t[:, :, None, :] + v_t[..., None] * k_t[:, :, None, :]
        return S, jnp.einsum('bhvk,bhk->bhv', S, r_t)

    S, ys = lax.scan(step, s0, xs, reverse=reverse)
    return S, jnp.moveaxis(ys, 0, 1)


def rwkv7_mix(pA, s0, lp):
    B, T, _ = pA.shape
    pA = token_shift(pA, lp['rw_mu'][0], lp['rw_mu'][1])
    r, k, v, wd, ad, gd = _split(pA, (MIX_A, MIX_A, MIX_A, RW_DECAY_LORA, RW_A_LORA, RW_GATE_LORA))
    a = jax.nn.sigmoid(lp['rw_a0'] + ad @ lp['rw_a_up'])
    g = jax.nn.sigmoid(gd) @ lp['rw_g_up']
    heads = lambda t: t.reshape(B, T, RW_HEADS, HEAD_DIM)
    kk = heads(k * lp['rw_k_k'])
    kk = kk / jnp.maximum(jnp.linalg.norm(kk, axis=-1, keepdims=True), 1e-12)
    k_eff = heads(k * (1 + (a - 1) * lp['rw_k_a']))
    r_h, v_h = heads(r), heads(v)
    kka = kk * heads(a)
    tw = jnp.tanh(wd)
    y = jnp.zeros_like(r_h)
    finals = []
    for d in range(2):
        w_log = -jax.nn.softplus(-(lp['rw_w0'][d] + tw @ lp['rw_w_up'][d])) - 0.5
        decay = heads(jnp.exp(-jnp.exp(w_log)))
        S, y_d = rwkv7_scan(r_h, decay, k_eff, v_h, kk, kka, s0[:, d], reverse=(d == 1))
        y = y + y_d
        finals.append(S)
    y = _norm_last(y, RW_EPS).reshape(B, T, MIX_A) * lp['rw_lnx_g'] + lp['rw_lnx_b']
    bonus = (jnp.sum(r_h * k_eff * lp['rw_r_k'], -1, keepdims=True) * v_h).reshape(B, T, MIX_A)
    return ((y + bonus) * g).astype(pA.dtype), jnp.stack(finals, 1)


def s5_scan(ab_re, ab_im, bu_re, bu_im, s0_re, s0_im, reverse):
    idx = -1 if reverse else 0
    bu_re = bu_re.at[:, idx].add(ab_re * s0_re - ab_im * s0_im)
    bu_im = bu_im.at[:, idx].add(ab_re * s0_im + ab_im * s0_re)
    T = bu_re.shape[1]
    a_re = jnp.broadcast_to(ab_re, (1, T) + ab_re.shape)
    a_im = jnp.broadcast_to(ab_im, (1, T) + ab_im.shape)

    def combine(e1, e2):
        ar1, ai1, br1, bi1 = e1
        ar2, ai2, br2, bi2 = e2
        return (ar1 * ar2 - ai1 * ai2, ar1 * ai2 + ai1 * ar2,
                ar2 * br1 - ai2 * bi1 + br2, ar2 * bi1 + ai2 * br1 + bi2)

    _, _, s_re, s_im = lax.associative_scan(combine, (a_re, a_im, bu_re, bu_im), reverse=reverse, axis=1)
    return s_re, s_im


def s5_mix(u, s0, lp):
    B, T, _ = u.shape
    ug = u.reshape(B, T, S5_GROUPS, S5_CH)
    y = jnp.zeros_like(ug)
    finals = []
    for d in range(2):
        dt = jnp.exp(lp['s5_log_dt'][d])[:, None]
        lam_re, lam_im = lp['s5_a_re'][d], lp['s5_a_im'][d]
        mag = jnp.exp(lam_re * dt)
        ab_re, ab_im = mag * jnp.cos(lam_im * dt), mag * jnp.sin(lam_im * dt)
        den = lam_re * lam_re + lam_im * lam_im
        z_re = ((ab_re - 1) * lam_re + ab_im * lam_im) / den
        z_im = (ab_im * lam_re - (ab_re - 1) * lam_im) / den
        bb_re = z_re[..., None] * lp['s5_b_re'] - z_im[..., None] * lp['s5_b_im']
        bb_im = z_re[..., None] * lp['s5_b_im'] + z_im[..., None] * lp['s5_b_re']
        bu_re = jnp.einsum('btgc,gnc->btgn', ug, bb_re)
        bu_im = jnp.einsum('btgc,gnc->btgn', ug, bb_im)
        s_re, s_im = s5_scan(ab_re, ab_im, bu_re, bu_im, s0[:, d, ..., 0], s0[:, d, ..., 1], reverse=(d == 1))
        y = y + jnp.einsum('btgn,gcn->btgc', s_re, lp['s5_c_re']) - jnp.einsum('btgn,gcn->btgc', s_im, lp['s5_c_im'])
        idx = 0 if d == 1 else -1
        finals.append(jnp.stack([s_re[:, idx], s_im[:, idx]], -1))
    y = y.reshape(B, T, MIX_B) + lp['s5_d'] * u
    gl = jax.nn.gelu(y)
    return gl * jax.nn.sigmoid(gl @ lp['s5_glu_w'] + lp['s5_glu_b']), jnp.stack(finals, 1)


def gla_chunk_scan(q, k, v, log_f, s0):
    B, T, H, dk = q.shape
    dv = v.shape[-1]
    n = T // HG_CHUNK
    to_chunks = lambda t: t.reshape(B, n, HG_CHUNK, H, t.shape[-1]).transpose(1, 0, 3, 2, 4)
    mask = jnp.tril(jnp.ones((HG_CHUNK, HG_CHUNK), bool))[:, :, None]

    def step(S, inp):
        qc, kc, vc, gc = inp
        b = jnp.cumsum(gc, axis=2)
        diff = b[:, :, :, None, :] - b[:, :, None, :, :]
        decay = jnp.where(mask, jnp.exp(jnp.where(mask, diff, 0.0)), 0.0)
        att = jnp.einsum('bhtd,bhsd,bhtsd->bhts', qc, kc, decay)
        o = att @ vc + jnp.einsum('bhtd,bhdv->bhtv', qc * jnp.exp(b), S)
        b_last = b[:, :, -1:, :]
        S = jnp.exp(b_last[:, :, 0, :, None]) * S + jnp.einsum('bhsd,bhsv->bhdv', kc * jnp.exp(b_last - b), vc)
        return S, o

    S, o = lax.scan(step, s0, tuple(to_chunks(t) for t in (q, k, v, log_f)))
    return S, o.transpose(1, 0, 3, 2, 4).reshape(B, T, H, dv)


def hgrn2_mix(pC, s0, lb, lp):
    B, T, _ = pC.shape
    q, f_fw, f_bw, i, g = _split(pC, (MIX_C,) * 5)
    heads = lambda t: t.reshape(B, T, HG_HEADS, HEAD_DIM)
    q, v = heads(jax.nn.silu(q)), heads(i)
    o = jnp.zeros_like(v)
    finals = []
    for d, fz in enumerate((f_fw, f_bw)):
        f = lb + (1 - lb) * jax.nn.sigmoid(fz.astype(jnp.float32))
        log_f = heads(jnp.log(jnp.maximum(f, F_TINY)).astype(pC.dtype))
        k = heads((1 - lb) * jax.nn.sigmoid(-fz))
        if d == 0:
            S, o_d = gla_chunk_scan(q, k, v, log_f, s0[:, d])
        else:
            S, o_d = gla_chunk_scan(*(jnp.flip(t, 1) for t in (q, k, v, log_f)), s0[:, d])
            o_d = jnp.flip(o_d, 1)
        o = o + o_d
        finals.append(S)
    of = o.astype(jnp.float32)
    of = of * lax.rsqrt(jnp.mean(jnp.square(of), -1, keepdims=True) + LN_EPS)
    out = of.reshape(B, T, MIX_C) * lp['hg_norm_g'] * jax.nn.silu(g)
    return out.astype(pC.dtype), jnp.stack(finals, 1)


def context_attention(q, k, v):
    B, S, H, d = q.shape
    nb = S // Q_BLOCK
    qb = q.reshape(B, nb, Q_BLOCK, H, d).transpose(1, 0, 2, 3, 4)
    scale = d ** -0.5

    def block(qi):
        s = jnp.einsum('bqhd,bkhd->bhqk', qi, k) * scale
        pr = jax.nn.softmax(s.astype(jnp.float32), axis=-1).astype(v.dtype)
        return jnp.einsum('bhqk,bkhd->bqhd', pr, v)

    out = lax.map(block, qb)
    return out.transpose(1, 0, 2, 3, 4).reshape(B, S, H * d)


def neighbourhood_attention(q, k, v, kc, vc, rpb):
    B, T, H, d = q.shape
    rows = T // GRID_W
    kr = min(NA_ROWS, rows)
    grid = lambda t: t.reshape(B, rows, GRID_W, H, d).transpose(0, 3, 1, 2, 4)
    qg, kg, vg = grid(q), grid(k), grid(v)
    cs = jnp.clip(jnp.arange(GRID_W) - NA_COLS // 2, 0, GRID_W - NA_COLS)
    col_idx = cs[:, None] + jnp.arange(NA_COLS)[None, :]
    dc = col_idx - jnp.arange(GRID_W)[:, None] + NA_COLS - 1
    scale = d ** -0.5
    n_loc = kr * NA_COLS

    def row_fn(r):
        rs = jnp.clip(r - kr // 2, 0, rows - kr)
        q_r = lax.dynamic_index_in_dim(qg, r, axis=2, keepdims=False)
        k_win = lax.dynamic_slice_in_dim(kg, rs, kr, axis=2)[:, :, :, col_idx]
        v_win = lax.dynamic_slice_in_dim(vg, rs, kr, axis=2)[:, :, :, col_idx]
        dr = rs + jnp.arange(kr) - r + NA_ROWS - 1
        bias = rpb[:, dr[None, :, None], dc[:, None, :]]
        s_loc = jnp.einsum('bhwd,bhiwjd->bhwij', q_r, k_win) * scale + bias
        s_ctx = jnp.einsum('bhwd,bphd->bhwp', q_r, kc) * scale
        s = jnp.concatenate([s_loc.reshape(B, H, GRID_W, n_loc), s_ctx], -1)
        pr = jax.nn.softmax(s.astype(jnp.float32), axis=-1).astype(v.dtype)
        p_loc = pr[..., :n_loc].reshape(B, H, GRID_W, kr, NA_COLS)
        return (jnp.einsum('bhwij,bhiwjd->bhwd', p_loc, v_win)
                + jnp.einsum('bhwp,bphd->bhwd', pr[..., n_loc:], vc))

    out = lax.map(row_fn, jnp.arange(rows))
    return out.transpose(1, 0, 3, 2, 4).reshape(B, T, H * d)


def trunk_layer(x, mod, lp, lb, ctx):
    sh1, sc1, g1, sh2, sc2, g2, sh3, sc3, g3 = jnp.split(mod, N_MOD, axis=-1)
    x = layer_norm(ALPHA * x + 0.5 * g1 * swiglu(modulate(x, sh1, sc1), lp['ffn_w_in'][0], lp['ffn_w_out'][0]),
                   lp['ln_g'][0], lp['ln_b'][0])
    B, T, _ = x.shape
    p = modulate(x, sh2, sc2) @ lp['w_in']
    pA, pB, pC, pD = _split(p, (RW_COLS, MIX_B, 5 * MIX_C, 3 * MIX_D))
    if ctx is None:
        s_rw = jnp.zeros((B, 2, RW_HEADS, HEAD_DIM, HEAD_DIM), x.dtype)
        s_s5 = jnp.zeros((B, 2, S5_GROUPS, S5_STATE, 2), x.dtype)
        s_hg = jnp.zeros((B, 2, HG_HEADS, HEAD_DIM, HEAD_DIM), x.dtype)
    else:
        k_ctx, v_ctx, s_rw, s_s5, s_hg = ctx
    oA, fA = rwkv7_mix(pA, s_rw, lp)
    oB, fB = s5_mix(pB, s_s5, lp)
    oC, fC = hgrn2_mix(pC, s_hg, lb, lp)
    q, k, v = (t.reshape(B, T, NA_HEADS, HEAD_DIM) for t in _split(pD, (MIX_D,) * 3))
    if ctx is None:
        oD = context_attention(q, k, v)
    else:
        oD = neighbourhood_attention(q, k, v, k_ctx, v_ctx, lp['na_rpb'])
    mix = jnp.concatenate([oA, oB, oC, oD], -1) @ lp['w_out']
    x = layer_norm(ALPHA * x + g2 * mix, lp['ln_g'][1], lp['ln_b'][1])
    x = layer_norm(ALPHA * x + 0.5 * g3 * swiglu(modulate(x, sh3, sc3), lp['ffn_w_in'][1], lp['ffn_w_out'][1]),
                   lp['ln_g'][2], lp['ln_b'][2])
    if ctx is None:
        return x, (k, v, fA, fB, fC)
    return x, None


def setup_inputs(seed: int = 0) -> dict:
    key = jax.random.key(seed)
    keys = jax.random.split(key, 48)
    kit = iter(range(48))
    nrm = lambda shape, s=1.0: s * jax.random.normal(keys[next(kit)], shape, jnp.float32)
    L = DEPTH
    n_idx = jnp.arange(S5_STATE, dtype=jnp.float32)
    return {
        'x_prompt': nrm((BATCH, SEQ, D_MODEL)),
        'x_sample': nrm((DEC_BATCH, DEC_SEQ, D_MODEL)),
        'cache_na_k': nrm((DEC_BATCH, DEPTH, PAST_LEN, NA_HEADS, HEAD_DIM)),
        'cache_na_v': nrm((DEC_BATCH, DEPTH, PAST_LEN, NA_HEADS, HEAD_DIM)),
        'state_rwkv': nrm((DEC_BATCH, DEPTH, 2, RW_HEADS, HEAD_DIM, HEAD_DIM), 0.3),
        'state_s5': nrm((DEC_BATCH, DEPTH, 2, S5_GROUPS, S5_STATE, 2), 0.1),
        'state_hgrn': nrm((DEC_BATCH, DEPTH, 2, HG_HEADS, HEAD_DIM, HEAD_DIM), 0.3),
        'c': nrm((DEC_BATCH, D_MODEL)),
        'c_ctx': nrm((D_MODEL,)),
        'w_mod': nrm((L, D_MODEL, N_MOD * D_MODEL), 0.5 * D_MODEL ** -0.5),
        'b_mod': nrm((L, N_MOD * D_MODEL), 0.02),
        'ln_g': 1.0 + nrm((L, 3, D_MODEL), 0.02),
        'ln_b': nrm((L, 3, D_MODEL), 0.02),
        'ffn_w_in': nrm((L, 2, D_MODEL, 2 * D_FF), D_MODEL ** -0.5),
        'ffn_w_out': nrm((L, 2, D_FF, D_MODEL), BETA * D_FF ** -0.5),
        'w_in': nrm((L, D_MODEL, IN_COLS), D_MODEL ** -0.5),
        'w_out': nrm((L, MIX_WIDTH, D_MODEL), BETA * MIX_WIDTH ** -0.5),
        'rw_mu': 0.25 + nrm((L, 2, RW_COLS), 0.05),
        'rw_w0': jnp.linspace(-6.0, -1.0, MIX_A) + 0.5 + nrm((L, 2, MIX_A), 0.1),
        'rw_w_up': nrm((L, 2, RW_DECAY_LORA, MIX_A), 0.5 * RW_DECAY_LORA ** -0.5),
        'rw_a0': nrm((L, MIX_A), 0.1),
        'rw_a_up': nrm((L, RW_A_LORA, MIX_A), 0.5 * RW_A_LORA ** -0.5),
        'rw_g_up': nrm((L, RW_GATE_LORA, MIX_A), RW_GATE_LORA ** -0.5),
        'rw_k_k': 0.85 + nrm((L, MIX_A), 0.02),
        'rw_k_a': 1.0 + nrm((L, MIX_A), 0.02),
        'rw_r_k': nrm((L, RW_HEADS, HEAD_DIM), 0.1),
        'rw_lnx_g': 1.0 + nrm((L, MIX_A), 0.02),
        'rw_lnx_b': nrm((L, MIX_A), 0.02),
        's5_a_re': -0.5 + nrm((L, 2, S5_GROUPS, S5_STATE), 0.01),
        's5_a_im': math.pi * n_idx + nrm((L, 2, S5_GROUPS, S5_STATE), 0.01),
        's5_log_dt': jax.random.uniform(keys[next(kit)], (L, 2, S5_GROUPS), jnp.float32,
                                        minval=math.log(1e-3), maxval=math.log(1e-1)),
        's5_b_re': nrm((L, S5_GROUPS, S5_STATE, S5_CH), (2 * S5_CH) ** -0.5),
        's5_b_im': nrm((L, S5_GROUPS, S5_STATE, S5_CH), (2 * S5_CH) ** -0.5),
        's5_c_re': nrm((L, S5_GROUPS, S5_CH, S5_STATE), S5_STATE ** -0.5),
        's5_c_im': nrm((L, S5_GROUPS, S5_CH, S5_STATE), S5_STATE ** -0.5),
        's5_d': nrm((L, MIX_B)),
        's5_glu_w': nrm((L, MIX_B, MIX_B), MIX_B ** -0.5),
        's5_glu_b': nrm((L, MIX_B), 0.02),
        'hg_lb': nrm((L, MIX_C)),
        'hg_norm_g': 1.0 + nrm((L, MIX_C), 0.02),
        'na_rpb': nrm((L, NA_HEADS, 2 * NA_ROWS - 1, 2 * NA_COLS - 1), 0.1),
    }


def reference(x_prompt, x_sample, cache_na_k, cache_na_v, state_rwkv, state_s5, state_hgrn, c, c_ctx,
              w_mod, b_mod, ln_g, ln_b, ffn_w_in, ffn_w_out, w_in, w_out,
              rw_mu, rw_w0, rw_w_up, rw_a0, rw_a_up, rw_g_up, rw_k_k, rw_k_a, rw_r_k, rw_lnx_g, rw_lnx_b,
              s5_a_re, s5_a_im, s5_log_dt, s5_b_re, s5_b_im, s5_c_re, s5_c_im, s5_d, s5_glu_w, s5_glu_b,
              hg_lb, hg_norm_g, na_rpb):
    lbs = jax.nn.softmax(hg_lb.astype(jnp.float32), axis=0)
    lb_all = (jnp.cumsum(lbs, axis=0) - lbs[0]).astype(hg_lb.dtype)
    y_p, y_s = x_prompt, x_sample
    nk, nv, nrw, ns5, nhg = [], [], [], [], []
    for l in range(DEPTH):
        lp = {
            'ffn_w_in': ffn_w_in[l], 'ffn_w_out': ffn_w_out[l], 'ln_g': ln_g[l], 'ln_b': ln_b[l],
            'w_in': w_in[l], 'w_out': w_out[l],
            'rw_mu': rw_mu[l], 'rw_w0': rw_w0[l], 'rw_w_up': rw_w_up[l], 'rw_a0': rw_a0[l],
            'rw_a_up': rw_a_up[l], 'rw_g_up': rw_g_up[l], 'rw_k_k': rw_k_k[l], 'rw_k_a': rw_k_a[l],
            'rw_r_k': rw_r_k[l], 'rw_lnx_g': rw_lnx_g[l], 'rw_lnx_b': rw_lnx_b[l],
            's5_a_re': s5_a_re[l], 's5_a_im': s5_a_im[l], 's5_log_dt': s5_log_dt[l],
            's5_b_re': s5_b_re[l], 's5_b_im': s5_b_im[l], 's5_c_re': s5_c_re[l], 's5_c_im': s5_c_im[l],
            's5_d': s5_d[l], 's5_glu_w': s5_glu_w[l], 's5_glu_b': s5_glu_b[l],
            'hg_norm_g': hg_norm_g[l], 'na_rpb': na_rpb[l],
        }
        mod_ctx = (jax.nn.silu(c_ctx) @ w_mod[l] + b_mod[l])[None, None, :]
        mod_lat = (jax.nn.silu(c) @ w_mod[l] + b_mod[l])[:, None, :]
        y_p, (k_l, v_l, s_rw, s_s5, s_hg) = trunk_layer(y_p, mod_ctx, lp, lb_all[l], None)
        y_s, _ = trunk_layer(y_s, mod_lat, lp, lb_all[l],
                             (cache_na_k[:, l], cache_na_v[:, l], state_rwkv[:, l], state_s5[:, l], state_hgrn[:, l]))
        nk.append(k_l)
        nv.append(v_l)
        nrw.append(s_rw)
        ns5.append(s_s5)
        nhg.append(s_hg)
    return (y_p, y_s, jnp.stack(nk, 1), jnp.stack(nv, 1), jnp.stack(nrw, 1), jnp.stack(ns5, 1), jnp.stack(nhg, 1))
```

```cpp
#include <hip/hip_runtime.h>
#include <hip/hip_cooperative_groups.h>
#include <stdint.h>
#include <cstdio>
namespace cg = cooperative_groups;

#ifndef MEGA
#define MEGA 1
#endif

typedef unsigned short u16;
typedef short bf16x8 __attribute__((ext_vector_type(8)));
typedef float f32x4 __attribute__((ext_vector_type(4)));
typedef unsigned u32x4 __attribute__((ext_vector_type(4)));
typedef unsigned u32x2 __attribute__((ext_vector_type(2)));

#define NCTX 8192
#define MTOK 40960
#define DFF 2816
#define ALPHA_F 1.41421356237f
#define NTHR 512

struct Params {
  const float *x_prompt, *x_sample, *cache_k, *cache_v, *st_rwkv, *st_s5, *st_hgrn, *c, *c_ctx;
  const float *w_mod, *b_mod, *ln_g, *ln_b, *ffn_w_in, *ffn_w_out, *w_in, *w_out;
  const float *rw_mu, *rw_w0, *rw_w_up, *rw_a0, *rw_a_up, *rw_g_up, *rw_k_k, *rw_k_a, *rw_r_k, *rw_lnx_g, *rw_lnx_b;
  const float *s5_a_re, *s5_a_im, *s5_log_dt, *s5_b_re, *s5_b_im, *s5_c_re, *s5_c_im, *s5_d, *s5_glu_w, *s5_glu_b;
  const float *hg_lb, *hg_norm_g, *na_rpb;
  float *X, *o_nak, *o_nav, *o_rwkv, *o_s5, *o_hgrn;
  u16 *WA0, *WA1, *WB0, *WB1, *WC, *WD;
  u16 *R1, *H, *PA, *PE0, *PE1, *YB;
  float* mod;
  unsigned* qctr;
};

#define DI __device__ __forceinline__

DI u16 f2bf(float f) { unsigned u = __float_as_uint(f); u += 0x7fffu + ((u >> 16) & 1u); return (u16)(u >> 16); }
DI float bf2f(u16 h) { return __uint_as_float(((unsigned)h) << 16); }
DI float bflo(unsigned w) { return __uint_as_float(w << 16); }
DI float bfhi(unsigned w) { return __uint_as_float(w & 0xffff0000u); }
DI unsigned pk2(float lo, float hi) { return (unsigned)f2bf(lo) | ((unsigned)f2bf(hi) << 16); }
DI float sigmoidf_(float x) { return 1.0f / (1.0f + __expf(-x)); }
DI float siluf_(float x) { return x / (1.0f + __expf(-x)); }
DI float wave_sum(float v) {
#pragma unroll
  for (int o = 32; o >= 1; o >>= 1) v += __shfl_xor(v, o);
  return v;
}
template <int CTRL> DI float dppf(float x) { return __builtin_bit_cast(float, __builtin_amdgcn_update_dpp(0, __builtin_bit_cast(int, x), CTRL, 0xF, 0xF, true)); }
DI float red8(float x) { x += dppf<0xB1>(x); x += dppf<0x4E>(x); x += dppf<0x141>(x); return x; }
DI int ltid() { int t = threadIdx.x; asm volatile("" : "+v"(t)); return t; }
DI int mrow_of(int m) { return m < NCTX ? 0 : 1 + ((m - NCTX) >> 12); }
DI void seq_info(int s, int& start, int& len) { if (s < 32) { start = s * 256; len = 256; } else { start = NCTX + (s - 32) * 4096; len = 4096; } }

namespace pg8 {
#define PG8_LAS __attribute__((address_space(3)))
typedef unsigned short bf16_t;
typedef short bf16x8 __attribute__((ext_vector_type(8)));
typedef float f32x4 __attribute__((ext_vector_type(4)));
typedef unsigned u32x4 __attribute__((ext_vector_type(4)));
constexpr int BM = 256, BK = 64, HALF = 128, HTB = HALF * BK * 2  , STAGE_BYTES = 8 * HTB, NXCD = 8, WGM = 8;

__host__ __device__ __forceinline__ int lds_byte(int r, int c) { const int st = (r >> 4) * 2 + (c >> 5), rr = r & 15, cc = c & 31, ob = rr * 64 + cc * 2; return st * 1024 + (ob ^ (((ob >> 9) & 1) << 5)); }
__host__ __device__ __forceinline__ void stage_rc(int b, int& R, int& C) { const int st = b / 1024, sb = b % 1024, swz = sb ^ (((sb >> 9) & 1) << 5); R = (st >> 1) * 16 + swz / 64; C = (st & 1) * 32 + (swz % 64) / 2; }
__host__ __device__ __forceinline__ int perm32(int rho) { const int n = rho >> 4, i = rho & 15; return 8 * (i >> 2) + 4 * n + (i & 3); }

struct Unit { int pm, pn; };
struct Gemm { const bf16_t* A; const bf16_t* Bt; int M, N, K; };

struct StaticOrder {
    int nM, nN, nwg, G, c;
    __host__ __device__ void init(int M, int N, int G_, int c_) { nM = M / BM; nN = N / BM; nwg = nM * nN; G = G_; c = c_; }
    __host__ __device__ bool next(int i, Unit& u) const {
        const long L = (long)i * G + c; if (L >= nwg) return false;
        int wgid = (int)L; { const int q = nwg / NXCD, r = nwg % NXCD, xcd = wgid % NXCD, off = wgid / NXCD; wgid = (xcd < r ? xcd * (q + 1) : r * (q + 1) + (xcd - r) * q) + off; }
        const int nig = WGM * nN, gid = wgid / nig, fm = gid * WGM, gsz = (nM - fm) < WGM ? (nM - fm) : WGM;
        u.pm = fm + ((wgid % nig) % gsz); u.pn = (wgid % nig) / gsz; return true;
    }
    __device__ __forceinline__ void a_ready(const Unit&) const {}
    __device__ __forceinline__ void done(const Unit&) const {}
};
__device__ __forceinline__ unsigned cvt_pk_bf16(float lo, float hi) { unsigned r; asm volatile("v_cvt_pk_bf16_f32 %0, %1, %2" : "=v"(r) : "v"(lo), "v"(hi)); return r; }
template <class Epi, class Sched, bool STAMP = false>
__device__ __forceinline__ void gemm_phase(PG8_LAS unsigned char* lds, const Gemm g, const Sched& S, const Epi& E, unsigned long long* stamps) {
    int tid = threadIdx.x; asm volatile("" : "+v"(tid)); const int wid = __builtin_amdgcn_readfirstlane(tid >> 6), lane = tid & 63, wr = wid >> 2, wc = wid & 3, fr = lane & 15, fq = lane >> 4;
    const int K = g.K, nt = K / BK;
    int ts_lo = 0, ts_hi = 0, nts = 0; const unsigned long long rt_entry = STAMP ? (unsigned long long)wall_clock64() : 0ull;
#define PG8_STAMP() do { if (STAMP && wid == 0 && nts < 64) { const unsigned long long _c = (unsigned long long)clock64(); \
        ts_lo = (lane == nts) ? (int)(unsigned)_c : ts_lo; ts_hi = (lane == nts) ? (int)(unsigned)(_c >> 32) : ts_hi; ++nts; } } while (0)
    PG8_STAMP();
    unsigned voffA[2], voffB[2];
#pragma unroll
    for (int i = 0; i < 2; ++i) { int R, C; stage_rc(tid * 16 + i * 8192, R, C); const int Rb = Epi::PERM ? ((R & ~31) + perm32(R & 31)) : R;
        voffA[i] = (unsigned)(R * K + C) * 2u; voffB[i] = (unsigned)(Rb * K + C) * 2u; }
    const size_t kstep = (size_t)(BK * 2);
    const size_t hstep = (size_t)HALF * K * 2;
    const size_t tstep = 2 * hstep;
    const unsigned ldsw = (unsigned)wid * 1024u;
    const int aoff = lds_byte(wr * 64 + fr, fq * 8), boff = lds_byte(wc * 32 + fr, fq * 8);
#define PG8_SA(b, h) (((b) * 2 + (h)) * HTB)
#define PG8_SB(b, h) ((4 + (b) * 2 + (h)) * HTB)
#define PG8_STAGE(bufoff, gbase, voff) do { _Pragma("unroll") for (int _i = 0; _i < 2; ++_i) \
        __builtin_amdgcn_global_load_lds((const unsigned*)((const char*)(gbase) + (voff)[_i]), (PG8_LAS unsigned*)(lds + (bufoff) + ldsw + _i * 8192), 16, 0, 0); } while (0)
#define PG8_LDA(dst, b, h) do { _Pragma("unroll") for (int m = 0; m < 4; ++m) _Pragma("unroll") for (int k = 0; k < 2; ++k) dst[m][k] = *(const PG8_LAS bf16x8*)(lds + PG8_SA(b, h) + aoff + m * 2048 + k * 1024); } while (0)
#define PG8_LDB(dst, b, h) do { _Pragma("unroll") for (int n = 0; n < 2; ++n) _Pragma("unroll") for (int k = 0; k < 2; ++k) dst[n][k] = *(const PG8_LAS bf16x8*)(lds + PG8_SB(b, h) + boff + n * 2048 + k * 1024); } while (0)
#define PG8_MMA(ai, bj, At, Bt) do { __builtin_amdgcn_s_setprio(1); _Pragma("unroll") for (int m = 0; m < 4; ++m) _Pragma("unroll") for (int n = 0; n < 2; ++n) _Pragma("unroll") for (int k = 0; k < 2; ++k) \
        acc[ai][bj][m][n] = __builtin_amdgcn_mfma_f32_16x16x32_bf16(Bt[n][k], At[m][k], acc[ai][bj][m][n], 0, 0, 0); __builtin_amdgcn_s_setprio(0); } while (0)
#define PG8_WAIT_V(n) asm volatile("s_waitcnt vmcnt(" #n ")" ::: "memory")
#define PG8_WAIT_L(n) asm volatile("s_waitcnt lgkmcnt(" #n ")" ::: "memory")
#define PG8_BAR __builtin_amdgcn_s_barrier()
#define PG8_SCHED __builtin_amdgcn_sched_barrier(0)
    Unit cur, nxt; int ui = 0;
    if (!S.next(0, cur)) return;
    f32x4 acc[2][2][4][2];
#pragma unroll
    for (int a = 0; a < 2; ++a)
#pragma unroll
        for (int b = 0; b < 2; ++b)
#pragma unroll
            for (int m = 0; m < 4; ++m)
#pragma unroll
                for (int n = 0; n < 2; ++n) acc[a][b][m][n] = (f32x4){0.f, 0.f, 0.f, 0.f};
    bf16x8 At[4][2], B0[2][2], B1[2][2];
    const char* cA = (const char*)g.A + (size_t)cur.pm * tstep; const char* cB = (const char*)g.Bt + (size_t)cur.pn * tstep;
    S.a_ready(cur);
    PG8_STAGE(PG8_SB(0, 0), cB, voffB); PG8_STAGE(PG8_SA(0, 0), cA, voffA); PG8_STAGE(PG8_SB(0, 1), cB + hstep, voffB); PG8_STAGE(PG8_SA(0, 1), cA + hstep, voffA);
    if (wr == 1) PG8_BAR;
    PG8_WAIT_V(4); PG8_BAR;
    PG8_STAGE(PG8_SB(1, 0), cB + kstep, voffB); PG8_STAGE(PG8_SA(1, 0), cA + kstep, voffA); PG8_STAGE(PG8_SB(1, 1), cB + hstep + kstep, voffB);
    PG8_WAIT_V(6); PG8_BAR;
    PG8_STAMP();
    for (;;) {
        const bool has_next = S.next(ui + 1, nxt);
        const char* nA = has_next ? (const char*)g.A + (size_t)nxt.pm * tstep : cA; const char* nB = has_next ? (const char*)g.Bt + (size_t)nxt.pn * tstep : cB;
        for (int t = 0; t < nt; t += 2) {
            const bool last = (t == nt - 2);
            const char* a1 = cA + (size_t)(t + 1) * kstep;
            const char* a2 = last ? nA : cA + (size_t)(t + 2) * kstep; const char* b2 = last ? nB : cB + (size_t)(t + 2) * kstep;
            const char* a3 = a2 + kstep; const char* b3 = b2 + kstep;
            if (last && has_next) S.a_ready(nxt);
            PG8_LDB(B0, 0, 0); PG8_SCHED; PG8_LDA(At, 0, 0); PG8_STAGE(PG8_SA(1, 1), a1 + hstep, voffA);
            PG8_WAIT_L(8); PG8_BAR; PG8_WAIT_L(0); PG8_MMA(0, 0, At, B0); PG8_BAR; PG8_SCHED;
            PG8_LDB(B1, 0, 1); PG8_STAGE(PG8_SB(0, 0), b2, voffB);
            PG8_BAR; PG8_WAIT_L(0); PG8_MMA(0, 1, At, B1); PG8_BAR;
            PG8_LDA(At, 0, 1); PG8_STAGE(PG8_SA(0, 0), a2, voffA);
            PG8_BAR; PG8_WAIT_L(0); PG8_MMA(1, 0, At, B0); PG8_BAR; PG8_SCHED;
            PG8_STAGE(PG8_SB(0, 1), b2 + hstep, voffB);
            PG8_WAIT_V(6); PG8_BAR; PG8_MMA(1, 1, At, B1); PG8_BAR;
            PG8_LDB(B0, 1, 0); PG8_SCHED; PG8_LDA(At, 1, 0); PG8_STAGE(PG8_SA(0, 1), a2 + hstep, voffA);
            PG8_WAIT_L(8); PG8_BAR; PG8_WAIT_L(0); PG8_MMA(0, 0, At, B0); PG8_BAR; PG8_SCHED;
            PG8_LDB(B1, 1, 1); PG8_STAGE(PG8_SB(1, 0), b3, voffB);
            PG8_BAR; PG8_WAIT_L(0); PG8_MMA(0, 1, At, B1); PG8_BAR;
            PG8_LDA(At, 1, 1); PG8_STAGE(PG8_SA(1, 0), a3, voffA);
            PG8_BAR; PG8_WAIT_L(0); PG8_MMA(1, 0, At, B0); PG8_BAR; PG8_SCHED;
            PG8_STAGE(PG8_SB(1, 1), b3 + hstep, voffB);
            PG8_WAIT_V(6); PG8_BAR; PG8_MMA(1, 1, At, B1); PG8_BAR;
        }
        PG8_STAMP();
        if constexpr (!Epi::AFTER_DRAIN) { E(acc, cur, wr, wc, fr, fq); S.done(cur); }
        PG8_STAMP();
        if (!has_next) break;
#pragma unroll
        for (int a = 0; a < 2; ++a)
#pragma unroll
            for (int b = 0; b < 2; ++b)
#pragma unroll
                for (int m = 0; m < 4; ++m)
#pragma unroll
                    for (int n = 0; n < 2; ++n) acc[a][b][m][n] = (f32x4){0.f, 0.f, 0.f, 0.f};
        cur = nxt; cA = nA; cB = nB; ++ui;
    }
    PG8_WAIT_V(0);
    if (wr == 0) PG8_BAR;
    PG8_BAR;
    if constexpr (Epi::AFTER_DRAIN) { E.fused(acc, cur, wr, wc, fr, fq, lds, wid, lane); S.done(cur); }
    PG8_STAMP();
    if (STAMP && wid == 0) { stamps[lane] = lane < nts ? (((unsigned long long)(unsigned)ts_hi << 32) | (unsigned)ts_lo) : 0ull;
        if (lane == 62) stamps[62] = rt_entry; if (lane == 63) stamps[63] = (unsigned long long)wall_clock64(); }
#undef PG8_STAMP
#undef PG8_SA
#undef PG8_SB
#undef PG8_STAGE
#undef PG8_LDA
#undef PG8_LDB
#undef PG8_MMA
#undef PG8_WAIT_V
#undef PG8_WAIT_L
#undef PG8_BAR
#undef PG8_SCHED
}
}

struct EpiSwiglu {
  static constexpr bool PERM = true, AFTER_DRAIN = false;
  u16* O;
  DI void operator()(const f32x4 (&acc)[2][2][4][2], const pg8::Unit& u, int wr, int wc, int fr, int fq) const {
    const int row0 = u.pm * 256 + wr * 64 + fr, col0 = u.pn * 128 + wc * 32 + 8 * fq;
#pragma unroll
    for (int ai = 0; ai < 2; ++ai)
#pragma unroll
      for (int m = 0; m < 4; ++m) {
        u16* rowp = O + (size_t)(row0 + ai * 128 + m * 16) * DFF + col0;
        f32x4 g0 = acc[ai][0][m][0], g1 = acc[ai][0][m][1], u0 = acc[ai][1][m][0], u1 = acc[ai][1][m][1];
        float v[8];
#pragma unroll
        for (int j = 0; j < 4; ++j) { v[j] = siluf_(g0[j]) * u0[j]; v[4 + j] = siluf_(g1[j]) * u1[j]; }
        u32x4 w; w.x = pg8::cvt_pk_bf16(v[0], v[1]); w.y = pg8::cvt_pk_bf16(v[2], v[3]); w.z = pg8::cvt_pk_bf16(v[4], v[5]); w.w = pg8::cvt_pk_bf16(v[6], v[7]);
        *(u32x4*)rowp = w;
      }
  }
};
struct EpiResid {
  static constexpr bool PERM = false, AFTER_DRAIN = false;
  const float* xp; const float* xs; float* X; const float* gate; float gs; int from_input;
  DI void operator()(const f32x4 (&acc)[2][2][4][2], const pg8::Unit& u, int wr, int wc, int fr, int fq) const {
    const int row0 = u.pm * 256 + wr * 64 + fr, col0 = u.pn * 256 + wc * 32 + 4 * fq;
#pragma unroll
    for (int ai = 0; ai < 2; ++ai)
#pragma unroll
      for (int m = 0; m < 4; ++m) {
        const int r = row0 + ai * 128 + m * 16;
        const float* xr = from_input ? (r < NCTX ? xp + (size_t)r * 1024 : xs + (size_t)(r - NCTX) * 1024) : X + (size_t)r * 1024;
        const float* gr = gate + (size_t)mrow_of(r) * 9216;
        float* orow = X + (size_t)r * 1024;
#pragma unroll
        for (int bj = 0; bj < 2; ++bj)
#pragma unroll
          for (int n = 0; n < 2; ++n) {
            const int c = col0 + bj * 128 + n * 16;
            const f32x4 x4 = *(const f32x4*)(xr + c), g4 = *(const f32x4*)(gr + c);
            *(f32x4*)(orow + c) = x4 * ALPHA_F + (g4 * gs) * acc[ai][bj][m][n];
          }
      }
  }
};
struct EpiP {
  static constexpr bool PERM = true, AFTER_DRAIN = false;
  u16* R1; float* nak; float* nav; int l;
  DI void operator()(const f32x4 (&acc)[2][2][4][2], const pg8::Unit& u, int wr, int wc, int fr, int fq) const {
    u16* base; int ldc, colt;
    if (u.pn < 4) { base = R1; ldc = 1024; colt = u.pn * 256; }
    else if (u.pn == 4) { base = R1 + (size_t)MTOK * 1024; ldc = 256; colt = 0; }
    else if (u.pn < 10) { base = R1 + (size_t)MTOK * 1280; ldc = 1280; colt = (u.pn - 5) * 256; }
    else { base = R1 + (size_t)MTOK * 2560; ldc = 768; colt = (u.pn - 10) * 256; }
    const int row0 = u.pm * 256 + wr * 64 + fr, cw = wc * 32 + 8 * fq;
    float* fdst = (u.pn == 11) ? nak : nav;
    const bool wf = (u.pn >= 11) && (u.pm < 32);
#pragma unroll
    for (int ai = 0; ai < 2; ++ai)
#pragma unroll
      for (int m = 0; m < 4; ++m) {
        const int r = row0 + ai * 128 + m * 16;
        u16* rowp = base + (size_t)r * ldc + colt + cw;
#pragma unroll
        for (int bj = 0; bj < 2; ++bj) {
          const f32x4 v0 = acc[ai][bj][m][0], v1 = acc[ai][bj][m][1];
          u32x4 w; w.x = pg8::cvt_pk_bf16(v0[0], v0[1]); w.y = pg8::cvt_pk_bf16(v0[2], v0[3]); w.z = pg8::cvt_pk_bf16(v1[0], v1[1]); w.w = pg8::cvt_pk_bf16(v1[2], v1[3]);
          *(u32x4*)(rowp + bj * 128) = w;
          if (wf) {
            float* fp = fdst + ((size_t)(((r >> 8) * 2 + l) * 256 + (r & 255))) * 256 + bj * 128 + cw;
            *(f32x4*)fp = v0; *(f32x4*)(fp + 4) = v1;
          }
        }
      }
  }
};

template <class Epi>
DI void run_gemm(PG8_LAS unsigned char* lds, const u16* A, const u16* Bt, int M, int N, int K, const Epi& E) {
  pg8::Gemm g; g.A = A; g.Bt = Bt; g.M = M; g.N = N; g.K = K;
  pg8::StaticOrder S; S.init(M, N, (int)gridDim.x, (int)blockIdx.x);
  pg8::gemm_phase<Epi, pg8::StaticOrder, false>(lds, g, S, E, nullptr);
}

DI void convert_tile(const float* src, u16* dst, int K, int N, int permmode, int tile, float* tl) {
  const int nK = K >> 6; const int nt = tile / nK, kt = tile - nt * nK;
  const int tidc = ltid(); const int tx = tidc & 63, ty = tidc >> 6;
  const int np = nt * 64 + tx; int sc = np;
  if (permmode) { const int t = np >> 8, c = np & 255; sc = (c < 128) ? (t * 128 + c) : (DFF + t * 128 + (c - 128)); }
#pragma unroll
  for (int i = 0; i < 8; ++i) { const int k = kt * 64 + ty + 8 * i; tl[(ty + 8 * i) * 65 + tx] = src[(size_t)k * N + sc]; }
  __syncthreads();
  const int r = tidc >> 3, c0 = (tidc & 7) * 8;
  u32x4 w;
  w.x = pk2(tl[(c0 + 0) * 65 + r], tl[(c0 + 1) * 65 + r]); w.y = pk2(tl[(c0 + 2) * 65 + r], tl[(c0 + 3) * 65 + r]);
  w.z = pk2(tl[(c0 + 4) * 65 + r], tl[(c0 + 5) * 65 + r]); w.w = pk2(tl[(c0 + 6) * 65 + r], tl[(c0 + 7) * 65 + r]);
  *(u32x4*)(dst + (size_t)(nt * 64 + r) * K + kt * 64 + c0) = w;
  __syncthreads();
}
#define NCONV 5312
DI void convert_job(const Params& P, int l, int job, float* tl) {
  if (job < 1408) convert_tile(P.ffn_w_in + (size_t)(l * 2 + 0) * 1024 * 5632, P.WA0, 1024, 5632, 1, job, tl);
  else if (job < 2816) convert_tile(P.ffn_w_in + (size_t)(l * 2 + 1) * 1024 * 5632, P.WA1, 1024, 5632, 1, job - 1408, tl);
  else if (job < 3520) convert_tile(P.ffn_w_out + (size_t)(l * 2 + 0) * DFF * 1024, P.WB0, DFF, 1024, 0, job - 2816, tl);
  else if (job < 4224) convert_tile(P.ffn_w_out + (size_t)(l * 2 + 1) * DFF * 1024, P.WB1, DFF, 1024, 0, job - 3520, tl);
  else if (job < 5056) convert_tile(P.w_in + (size_t)l * 1024 * 3328, P.WC, 1024, 3328, 0, job - 4224, tl);
  else convert_tile(P.w_out + (size_t)l * 1024 * 1024, P.WD, 1024, 1024, 0, job - 5056, tl);
}
DI void phase_p0(const Params& P, unsigned char* lds) {
  float* tl = (float*)lds;
  float* sc = (float*)(lds + 16640);
  float* red = (float*)(lds + 16640 + 36864);
  const int tid = ltid();
  if (blockIdx.x == 0 && tid < 4) P.qctr[tid] = 0u;
  for (int i = tid; i < 9216; i += NTHR) { const int r = i >> 10, k = i & 1023; const float v = (r == 0) ? P.c_ctx[k] : P.c[(r - 1) * 1024 + k]; sc[i] = siluf_(v); }
  __syncthreads();
  for (int job = blockIdx.x; job < NCONV + 288; job += gridDim.x) {
    if (job < NCONV) { convert_job(P, 0, job, tl); continue; }
    const int jm = job - NCONV; const int l = jm / 144, col0 = (jm % 144) * 64;
    const int col = tid & 63, kg = tid >> 6;
    float acc[9];
#pragma unroll
    for (int r = 0; r < 9; ++r) acc[r] = 0.f;
    const float* wp = P.w_mod + (size_t)l * 1024 * 9216 + col0 + col;
    for (int k = kg * 128; k < kg * 128 + 128; ++k) {
      const float w = wp[(size_t)k * 9216];
#pragma unroll
      for (int r = 0; r < 9; ++r) acc[r] += sc[r * 1024 + k] * w;
    }
#pragma unroll
    for (int r = 0; r < 9; ++r) red[(kg * 9 + r) * 64 + col] = acc[r];
    __syncthreads();
    for (int i = tid; i < 576; i += NTHR) {
      const int r = i >> 6, cc = i & 63; float s = P.b_mod[l * 9216 + col0 + cc];
#pragma unroll
      for (int g = 0; g < 8; ++g) s += red[(g * 9 + r) * 64 + cc];
      P.mod[(size_t)(l * 9 + r) * 9216 + col0 + cc] = s;
    }
    __syncthreads();
  }
}

DI void phase_lnmod(const Params& P, const float* lng, const float* lnb, const float* modl, int shoff, int from_input) {
  const int tidl = ltid(); const int wid = tidl >> 6, lane = tidl & 63;
  for (int m = blockIdx.x * 8 + wid; m < MTOK; m += gridDim.x * 8) {
    const float* src = from_input ? (m < NCTX ? P.x_prompt + (size_t)m * 1024 : P.x_sample + (size_t)(m - NCTX) * 1024) : P.X + (size_t)m * 1024;
    f32x4 v[4];
#pragma unroll
    for (int i = 0; i < 4; ++i) v[i] = *(const f32x4*)(src + lane * 4 + 256 * i);
    if (lng) {
      float s = 0.f;
#pragma unroll
      for (int i = 0; i < 4; ++i) s += (v[i][0] + v[i][1]) + (v[i][2] + v[i][3]);
      s = wave_sum(s); const float mean = s * (1.0f / 1024.0f);
      float q = 0.f;
#pragma unroll
      for (int i = 0; i < 4; ++i) { const f32x4 d = v[i] - mean; q += (d[0] * d[0] + d[1] * d[1]) + (d[2] * d[2] + d[3] * d[3]); }
      q = wave_sum(q); const float rstd = 1.0f / sqrtf(q * (1.0f / 1024.0f) + 1e-5f);
#pragma unroll
      for (int i = 0; i < 4; ++i) {
        const int c = lane * 4 + 256 * i;
        const f32x4 g = *(const f32x4*)(lng + c), b = *(const f32x4*)(lnb + c);
        v[i] = (v[i] - mean) * rstd * g + b;
        *(f32x4*)(P.X + (size_t)m * 1024 + c) = v[i];
      }
    }
    if (modl) {
      const float* mr = modl + (size_t)mrow_of(m) * 9216 + shoff * 1024;
#pragma unroll
      for (int i = 0; i < 4; ++i) {
        const int c = lane * 4 + 256 * i;
        const f32x4 sh = *(const f32x4*)(mr + c), scl = *(const f32x4*)(mr + 1024 + c);
        const f32x4 h = v[i] * (scl + 1.0f) + sh;
        u32x2 w; w.x = pk2(h[0], h[1]); w.y = pk2(h[2], h[3]);
        *(u32x2*)(P.H + (size_t)m * 1024 + c) = w;
      }
    }
  }
}

DI void phase_prep(const Params& P, int l, unsigned char* lds) {
  float* twT = (float*)lds;
  float* adT = twT + 64 * 32;
  const int tid = ltid();
  const float* mu_p = P.rw_mu + (size_t)(l * 2 + 0) * 1024, *mu_n = P.rw_mu + (size_t)(l * 2 + 1) * 1024;
  for (int job = blockIdx.x; job < MTOK / 32; job += gridDim.x) {
    const int m0 = job * 32;
    {
      const int t = tid >> 4, cg = tid & 15; const int m = m0 + t;
      int start, len; const int s = m < NCTX ? (m >> 8) : 32 + ((m - NCTX) >> 12); seq_info(s, start, len);
      const int tt = m - start; const int col = 768 + cg * 8;
      const u16* p0 = P.R1 + (size_t)m * 1024 + col;
      u32x4 c = *(const u32x4*)p0, pv = {0, 0, 0, 0}, nx = {0, 0, 0, 0};
      if (tt > 0) pv = *(const u32x4*)(p0 - 1024);
      if (tt < len - 1) nx = *(const u32x4*)(p0 + 1024);
#pragma unroll
      for (int i = 0; i < 8; ++i) {
        const unsigned cw = c[i >> 1], pw = pv[i >> 1], nw = nx[i >> 1];
        const float x = (i & 1) ? bfhi(cw) : bflo(cw), xp = (i & 1) ? bfhi(pw) : bflo(pw), xn = (i & 1) ? bfhi(nw) : bflo(nw);
        const float sh = x + mu_p[col + i] * (xp - x) + mu_n[col + i] * (xn - x);
        const int j = cg * 8 + i;
        if (j < 64) twT[j * 32 + t] = tanhf(sh); else adT[(j - 64) * 32 + t] = sh;
      }
    }
    __syncthreads();
    const int c = tid & 255, hf = tid >> 8;
    float aa[16], e0[16], e1[16];
#pragma unroll
    for (int t = 0; t < 16; ++t) { aa[t] = 0.f; e0[t] = 0.f; e1[t] = 0.f; }
    const float* wa = P.rw_a_up + (size_t)l * 64 * 256 + c;
    const float* w0 = P.rw_w_up + (size_t)(l * 2 + 0) * 64 * 256 + c;
    const float* w1 = P.rw_w_up + (size_t)(l * 2 + 1) * 64 * 256 + c;
    for (int j = 0; j < 64; ++j) {
      const float fa = wa[j * 256], f0 = w0[j * 256], f1 = w1[j * 256];
      const f32x4* tp = (const f32x4*)(twT + j * 32 + hf * 16); const f32x4* ap = (const f32x4*)(adT + j * 32 + hf * 16);
#pragma unroll
      for (int q = 0; q < 4; ++q) { const f32x4 tv = tp[q], av = ap[q];
#pragma unroll
        for (int i = 0; i < 4; ++i) { aa[q * 4 + i] += av[i] * fa; e0[q * 4 + i] += tv[i] * f0; e1[q * 4 + i] += tv[i] * f1; } }
    }
    const float a0 = P.rw_a0[l * 256 + c], b0 = P.rw_w0[(l * 2 + 0) * 256 + c], b1 = P.rw_w0[(l * 2 + 1) * 256 + c];
#pragma unroll
    for (int t = 0; t < 16; ++t) {
      const size_t o = (size_t)(m0 + hf * 16 + t) * 256 + c;
      P.PA[o] = f2bf(sigmoidf_(a0 + aa[t]));
      P.PE0[o] = f2bf(0.60653066f * sigmoidf_(b0 + e0[t]));
      P.PE1[o] = f2bf(0.60653066f * sigmoidf_(b1 + e1[t]));
    }
    __syncthreads();
  }
}

DI void rwkv_unit(const Params& P, int l, int s, int h, int d, unsigned char* lds) {
  int tid = threadIdx.x; asm volatile("" : "+v"(tid)); const int wid = tid >> 6, lane = tid & 63;
  const int row = wid * 8 + (lane >> 3), kq = lane & 7;
  int start, len; seq_info(s, start, len);
  float* buf = (float*)lds;
  float* yst = buf + 2 * 6 * 1024;
  float S[8];
  if (s >= 32) {
    const float* sp = P.st_rwkv + ((((size_t)(s - 32) * 2 + l) * 2 + d) * 4 + h) * 4096 + row * 64 + kq * 8;
    const f32x4 a = *(const f32x4*)sp, b = *(const f32x4*)(sp + 4);
#pragma unroll
    for (int i = 0; i < 4; ++i) { S[i] = a[i]; S[4 + i] = b[i]; }
  } else {
#pragma unroll
    for (int i = 0; i < 8; ++i) S[i] = 0.f;
  }
  const int ptok = tid >> 5, pc = (tid & 31) * 2;
  float mup[3][2], mun[3][2];
#pragma unroll
  for (int k = 0; k < 3; ++k)
#pragma unroll
    for (int e = 0; e < 2; ++e) { mup[k][e] = P.rw_mu[(size_t)(l * 2 + 0) * 1024 + k * 256 + h * 64 + pc + e]; mun[k][e] = P.rw_mu[(size_t)(l * 2 + 1) * 1024 + k * 256 + h * 64 + pc + e]; }
  const float kk0 = P.rw_k_k[l * 256 + h * 64 + pc], kk1 = P.rw_k_k[l * 256 + h * 64 + pc + 1];
  const float ka0 = P.rw_k_a[l * 256 + h * 64 + pc], ka1 = P.rw_k_a[l * 256 + h * 64 + pc + 1];
  const u16* pe = d ? P.PE1 : P.PE0;
  u16* outp = d ? P.YB : P.H; const int ldo = d ? 256 : 1024;
  const int nch = len >> 4;
  unsigned raw[11];
#define RW_ISSUE(ci) do { const int t0_ = d ? (len - 16 - (ci) * 16) : (ci) * 16; const int t_ = t0_ + ptok; const size_t m_ = (size_t)(start + t_); \
    _Pragma("unroll") for (int k_ = 0; k_ < 3; ++k_) { const u16* p_ = P.R1 + m_ * 1024 + k_ * 256 + h * 64 + pc; \
      raw[k_ * 3 + 0] = (t_ > 0) ? *(const unsigned*)(p_ - 1024) : 0u; raw[k_ * 3 + 1] = *(const unsigned*)p_; raw[k_ * 3 + 2] = (t_ < len - 1) ? *(const unsigned*)(p_ + 1024) : 0u; } \
    raw[9] = *(const unsigned*)(P.PA + m_ * 256 + h * 64 + pc); raw[10] = *(const unsigned*)(pe + m_ * 256 + h * 64 + pc); } while (0)
#define RW_FLUSH(ci, b) do { const int t0_ = d ? (len - 16 - (ci) * 16) : (ci) * 16; const float* y_ = yst + (b) * 1024 + ptok * 64 + pc; \
    *(unsigned*)(outp + (size_t)(start + t0_ + ptok) * ldo + h * 64 + pc) = pk2(y_[0], y_[1]); } while (0)
  RW_ISSUE(0);
  for (int ci = 0; ci < nch; ++ci) {
    const int b = ci & 1;
    {
      float sh[3][2];
#pragma unroll
      for (int k = 0; k < 3; ++k) {
        const unsigned pw = raw[k * 3], cw = raw[k * 3 + 1], nw = raw[k * 3 + 2];
        const float c0 = bflo(cw), c1 = bfhi(cw);
        sh[k][0] = c0 + mup[k][0] * (bflo(pw) - c0) + mun[k][0] * (bflo(nw) - c0);
        sh[k][1] = c1 + mup[k][1] * (bfhi(pw) - c1) + mun[k][1] * (bfhi(nw) - c1);
      }
      const float a0 = bflo(raw[9]), a1 = bfhi(raw[9]), e0 = bflo(raw[10]), e1 = bfhi(raw[10]);
      const float q0 = sh[1][0] * kk0, q1 = sh[1][1] * kk1;
      float ss = q0 * q0 + q1 * q1;
      ss += __shfl_xor(ss, 1); ss += __shfl_xor(ss, 2); ss += __shfl_xor(ss, 4); ss += __shfl_xor(ss, 8); ss += __shfl_xor(ss, 16);
      const float inv = 1.0f / fmaxf(sqrtf(ss), 1e-12f);
      const float n0 = q0 * inv, n1 = q1 * inv;
      float* B = buf + b * 6144 + ptok * 64 + pc;
      *(float2*)(B + 0 * 1024) = make_float2(sh[0][0], sh[0][1]);
      *(float2*)(B + 1 * 1024) = make_float2(__expf(-e0), __expf(-e1));
      *(float2*)(B + 2 * 1024) = make_float2(sh[1][0] * (1.f + (a0 - 1.f) * ka0), sh[1][1] * (1.f + (a1 - 1.f) * ka1));
      *(float2*)(B + 3 * 1024) = make_float2(sh[2][0], sh[2][1]);
      *(float2*)(B + 4 * 1024) = make_float2(n0, n1);
      *(float2*)(B + 5 * 1024) = make_float2(n0 * a0, n1 * a1);
    }
    __syncthreads();
    if (ci > 0) RW_FLUSH(ci - 1, b ^ 1);
    if (ci + 1 < nch) RW_ISSUE(ci + 1);
#pragma unroll 4
    for (int st = 0; st < 16; ++st) {
      const int tt = d ? 15 - st : st;
      const float* B = buf + b * 6144 + tt * 64 + kq * 8;
      const f32x4 r0 = *(const f32x4*)(B), r1 = *(const f32x4*)(B + 4);
      const f32x4 w0 = *(const f32x4*)(B + 1024), w1 = *(const f32x4*)(B + 1024 + 4);
      const f32x4 k0 = *(const f32x4*)(B + 2048), k1 = *(const f32x4*)(B + 2048 + 4);
      const f32x4 c0 = *(const f32x4*)(B + 4096), c1 = *(const f32x4*)(B + 4096 + 4);
      const f32x4 b0 = *(const f32x4*)(B + 5120), b1 = *(const f32x4*)(B + 5120 + 4);
      const float vv = buf[b * 6144 + 3 * 1024 + tt * 64 + row];
      float sa = 0.f;
#pragma unroll
      for (int i = 0; i < 4; ++i) { sa += S[i] * c0[i]; sa += S[4 + i] * c1[i]; }
      sa = -red8(sa);
#pragma unroll
      for (int i = 0; i < 4; ++i) { S[i] = S[i] * w0[i] + (sa * b0[i] + vv * k0[i]); S[4 + i] = S[4 + i] * w1[i] + (sa * b1[i] + vv * k1[i]); }
      float y = 0.f;
#pragma unroll
      for (int i = 0; i < 4; ++i) { y += S[i] * r0[i]; y += S[4 + i] * r1[i]; }
      y = red8(y);
      if (kq == 0) yst[b * 1024 + tt * 64 + row] = y;
    }
  }
  __syncthreads();
  RW_FLUSH(nch - 1, (nch - 1) & 1);
  if (s < 32) {
    float* op = P.o_rwkv + ((((size_t)s * 2 + l) * 2 + d) * 4 + h) * 4096 + row * 64 + kq * 8;
    *(f32x4*)op = (f32x4){S[0], S[1], S[2], S[3]}; *(f32x4*)(op + 4) = (f32x4){S[4], S[5], S[6], S[7]};
  }
  __syncthreads();
#undef RW_ISSUE
#undef RW_FLUSH
}

DI void hgrn_unit(const Params& P, int l, int s, int h, int d, unsigned char* lds) {
  int tid = threadIdx.x; asm volatile("" : "+v"(tid)); const int wid = tid >> 6, lane = tid & 63;
  const int col = wid * 8 + (lane >> 3), kq = lane & 7;
  int start, len; seq_info(s, start, len);
  float* buf = (float*)lds;
  float* yst = buf + 2 * 4 * 1024;
  float S[8];
  if (s >= 32) {
    const float* sp = P.st_hgrn + ((((size_t)(s - 32) * 2 + l) * 2 + d) * 4 + h) * 4096;
#pragma unroll
    for (int i = 0; i < 8; ++i) S[i] = sp[(kq * 8 + i) * 64 + col];
  } else {
#pragma unroll
    for (int i = 0; i < 8; ++i) S[i] = 0.f;
  }
  const int ptok = tid >> 5, pc = (tid & 31) * 2;
  float lb0 = 0.f, lb1 = 0.f;
  if (l == 1) {
    const float h00 = P.hg_lb[h * 64 + pc], h01 = P.hg_lb[h * 64 + pc + 1], h10 = P.hg_lb[256 + h * 64 + pc], h11 = P.hg_lb[256 + h * 64 + pc + 1];
    lb0 = 1.0f / (1.0f + expf(h00 - h10)); lb1 = 1.0f / (1.0f + expf(h01 - h11));
  }
  const u16* pC = P.R1 + (size_t)MTOK * 1280;
  u16* outp = d ? (P.YB + (size_t)MTOK * 512) : P.H; const int ldo = d ? 256 : 1024; const int coff = d ? 0 : 512;
  const int nch = len >> 4;
  unsigned raw[3];
#define HG_ISSUE(ci) do { const int t0_ = d ? (len - 16 - (ci) * 16) : (ci) * 16; const u16* p_ = pC + (size_t)(start + t0_ + ptok) * 1280 + h * 64 + pc; \
    raw[0] = *(const unsigned*)p_; raw[1] = *(const unsigned*)(p_ + 256 * (1 + d)); raw[2] = *(const unsigned*)(p_ + 768); } while (0)
#define HG_FLUSH(ci, b) do { const int t0_ = d ? (len - 16 - (ci) * 16) : (ci) * 16; const float* y_ = yst + (b) * 1024 + ptok * 64 + pc; \
    *(unsigned*)(outp + (size_t)(start + t0_ + ptok) * ldo + coff + h * 64 + pc) = pk2(y_[0], y_[1]); } while (0)
  HG_ISSUE(0);
  for (int ci = 0; ci < nch; ++ci) {
    const int b = ci & 1;
    {
      const float q0 = bflo(raw[0]), q1 = bfhi(raw[0]), z0 = bflo(raw[1]), z1 = bfhi(raw[1]);
      const float s0 = sigmoidf_(z0), s1 = sigmoidf_(z1);
      const float f0 = fmaxf(lb0 + (1.f - lb0) * s0, 1e-30f), f1 = fmaxf(lb1 + (1.f - lb1) * s1, 1e-30f);
      const float k0 = (1.f - lb0) / (1.f + __expf(z0)), k1 = (1.f - lb1) / (1.f + __expf(z1));
      float* B = buf + b * 4096 + ptok * 64 + pc;
      *(float2*)(B) = make_float2(f0, f1);
      *(float2*)(B + 1024) = make_float2(k0, k1);
      *(float2*)(B + 2048) = make_float2(siluf_(q0), siluf_(q1));
      *(float2*)(B + 3072) = make_float2(bflo(raw[2]), bfhi(raw[2]));
    }
    __syncthreads();
    if (ci > 0) HG_FLUSH(ci - 1, b ^ 1);
    if (ci + 1 < nch) HG_ISSUE(ci + 1);
#pragma unroll 4
    for (int st = 0; st < 16; ++st) {
      const int tt = d ? 15 - st : st;
      const float* B = buf + b * 4096 + tt * 64 + kq * 8;
      const f32x4 f0 = *(const f32x4*)(B), f1 = *(const f32x4*)(B + 4);
      const f32x4 k0 = *(const f32x4*)(B + 1024), k1 = *(const f32x4*)(B + 1024 + 4);
      const f32x4 q0 = *(const f32x4*)(B + 2048), q1 = *(const f32x4*)(B + 2048 + 4);
      const float vv = buf[b * 4096 + 3072 + tt * 64 + col];
      float o = 0.f;
#pragma unroll
      for (int i = 0; i < 4; ++i) { S[i] = f0[i] * S[i] + k0[i] * vv; S[4 + i] = f1[i] * S[4 + i] + k1[i] * vv; o += S[i] * q0[i]; o += S[4 + i] * q1[i]; }
      o = red8(o);
      if (kq == 0) yst[b * 1024 + tt * 64 + col] = o;
    }
  }
  __syncthreads();
  HG_FLUSH(nch - 1, (nch - 1) & 1);
  if (s < 32) {
    float* op = P.o_hgrn + ((((size_t)s * 2 + l) * 2 + d) * 4 + h) * 4096;
#pragma unroll
    for (int i = 0; i < 8; ++i) op[(kq * 8 + i) * 64 + col] = S[i];
  }
  __syncthreads();
#undef HG_ISSUE
#undef HG_FLUSH
}

DI void s5_block(const Params& P, int l, int s, int d, int goct, unsigned char* lds) {
  int tid = threadIdx.x; asm volatile("" : "+v"(tid)); const int wid = tid >> 6, lane = tid & 63, fr = lane & 15, fq = lane >> 4;
  const int g = goct * 8 + wid;
  int start, len; seq_info(s, start, len);
  float* bu = (float*)(lds + wid * 12800);
  u16* sb = (u16*)(lds + wid * 12800 + 8448);
  float abr, abi, zr, zi;
  {
    const float dt = expf(P.s5_log_dt[(l * 2 + d) * 16 + g]);
    const float lre = P.s5_a_re[(size_t)((l * 2 + d) * 16 + g) * 64 + lane], lim = P.s5_a_im[(size_t)((l * 2 + d) * 16 + g) * 64 + lane];
    const float x = lre * dt, th = lim * dt; const float mag = expf(x); float sn, cs; sincosf(th, &sn, &cs);
    abr = mag * cs; abi = mag * sn;
    const float shalf = sinf(0.5f * th); const float abm1 = expm1f(x) * cs - 2.0f * shalf * shalf;
    const float den = lre * lre + lim * lim;
    zr = (abm1 * lre + abi * lim) / den; zi = (abi * lre - abm1 * lim) / den;
  }
  bf16x8 bbf[8], ccf[4];
#pragma unroll
  for (int nt = 0; nt < 8; ++nt) {
    const int nsrc = nt * 8 + (fr >> 1), ri = fr & 1;
    const float z_r = __shfl(zr, nsrc), z_i = __shfl(zi, nsrc);
    const float* br = P.s5_b_re + ((size_t)(l * 16 + g) * 64 + nsrc) * 16; const float* bi = P.s5_b_im + ((size_t)(l * 16 + g) * 64 + nsrc) * 16;
#pragma unroll
    for (int j = 0; j < 8; ++j) {
      float v = 0.f;
      if (fq < 2) { const float b_r = br[fq * 8 + j], b_i = bi[fq * 8 + j]; v = ri ? (z_r * b_i + z_i * b_r) : (z_r * b_r - z_i * b_i); }
      bbf[nt][j] = (short)f2bf(v);
    }
  }
#pragma unroll
  for (int ks = 0; ks < 4; ++ks)
#pragma unroll
    for (int j = 0; j < 8; ++j) {
      const int n = ks * 16 + fq * 4 + (j >> 1);
      const size_t ix = ((size_t)(l * 16 + g) * 16 + fr) * 64 + n;
      ccf[ks][j] = (short)f2bf((j & 1) ? -P.s5_c_im[ix] : P.s5_c_re[ix]);
    }
  float sre = 0.f, sim = 0.f;
  if (s >= 32) { const float* sp = P.st_s5 + (((((size_t)(s - 32) * 2 + l) * 2 + d) * 16 + g) * 64 + lane) * 2; sre = sp[0]; sim = sp[1]; }
  const u16* pB = P.R1 + (size_t)MTOK * 1024;
  u16* outp = d ? (P.YB + (size_t)MTOK * 256) : P.H; const int ldo = d ? 256 : 1024; const int coff = d ? 0 : 256;
  const int nch = len >> 4;
  const u32x4 zero4 = {0u, 0u, 0u, 0u};
#define S5_LOADU(ci) ((fq < 2) ? *(const u32x4*)(pB + (size_t)(start + (d ? (len - 16 - (ci) * 16) : (ci) * 16) + fr) * 256 + g * 16 + fq * 8) : zero4)
  u32x4 u0 = S5_LOADU(0), u1 = zero4, u2 = zero4;
  if (nch > 1) u1 = S5_LOADU(1);
  if (nch > 2) u2 = S5_LOADU(2);
  for (int ci = 0; ci < nch; ++ci) {
    const u32x4 uc = u0; u0 = u1; u1 = u2; if (ci + 3 < nch) u2 = S5_LOADU(ci + 3);
    const bf16x8 ua = __builtin_bit_cast(bf16x8, uc);
#pragma unroll
    for (int nt = 0; nt < 8; ++nt) {
      f32x4 acc = {0.f, 0.f, 0.f, 0.f};
      acc = __builtin_amdgcn_mfma_f32_16x16x32_bf16(ua, bbf[nt], acc, 0, 0, 0);
#pragma unroll
      for (int j = 0; j < 4; ++j) bu[(fq * 4 + j) * 132 + nt * 16 + fr] = acc[j];
    }
    __syncthreads();
#pragma unroll 4
    for (int st = 0; st < 16; ++st) {
      const int tt = d ? 15 - st : st;
      const float2 b2 = *(const float2*)(bu + tt * 132 + 2 * lane);
      const float nr = abr * sre - abi * sim + b2.x, ni = abr * sim + abi * sre + b2.y;
      sre = nr; sim = ni;
      *(unsigned*)(sb + tt * 136 + 2 * lane) = pk2(sre, sim);
    }
    __syncthreads();
    f32x4 acc = {0.f, 0.f, 0.f, 0.f};
#pragma unroll
    for (int ks = 0; ks < 4; ++ks) {
      const bf16x8 a = *(const bf16x8*)(sb + fr * 136 + ks * 32 + fq * 8);
      acc = __builtin_amdgcn_mfma_f32_16x16x32_bf16(a, ccf[ks], acc, 0, 0, 0);
    }
    const int t0 = d ? (len - 16 - ci * 16) : ci * 16;
#pragma unroll
    for (int j = 0; j < 4; ++j) outp[(size_t)(start + t0 + fq * 4 + j) * ldo + coff + g * 16 + fr] = f2bf(acc[j]);
    __syncthreads();
  }
  if (s < 32) { float* op = P.o_s5 + (((((size_t)s * 2 + l) * 2 + d) * 16 + g) * 64 + lane) * 2; op[0] = sre; op[1] = sim; }
#undef S5_LOADU
}

DI void attn_job(const Params& P, int l, int type, int b, int rq, int hp, unsigned char* lds) {
  int tid = threadIdx.x; asm volatile("" : "+v"(tid)); const int wid = tid >> 6, lane = tid & 63, fr = lane & 15, fq = lane >> 4;
  const int hh = wid >> 2, qg = wid & 3, head = hp * 2 + hh;
  const u16* pD = P.R1 + (size_t)MTOK * 2560;
  unsigned char* ldsK = lds;
  u16* ldsV = (u16*)(lds + 32768);
  float* rpbL = (float*)(lds + 32768 + 36864);
  const int mq0 = type == 0 ? (NCTX + b * 4096 + rq * 64) : (b * 256 + rq * 64);
  const int mq = mq0 + qg * 16 + fr;
  bf16x8 qf[2];
  qf[0] = *(const bf16x8*)(pD + (size_t)mq * 768 + head * 64 + fq * 8);
  qf[1] = *(const bf16x8*)(pD + (size_t)mq * 768 + head * 64 + 32 + fq * 8);
  const int nchunks = type == 0 ? 12 : 4, nloc = type == 0 ? 8 : 4;
  const int rs = type == 0 ? min(max(rq - 4, 0), 56) : 0;
  const int mk0 = type == 0 ? (NCTX + b * 4096 + rs * 64) : (b * 256);
  if (type == 0) for (int i = tid; i < 930; i += NTHR) rpbL[i] = P.na_rpb[(size_t)(l * 4 + hp * 2) * 465 + i];
  const int sh = tid >> 8, skey = (tid >> 2) & 63, sdq = tid & 3, shead = hp * 2 + sh;
  u32x4 kr[4], vr[4];
#define AT_ISSUE(ci) do { if ((ci) < nloc) { const u16* kp_ = pD + (size_t)(mk0 + (ci) * 64 + skey) * 768 + 256 + shead * 64 + sdq * 16; \
      kr[0] = *(const u32x4*)kp_; kr[1] = *(const u32x4*)(kp_ + 8); vr[0] = *(const u32x4*)(kp_ + 256); vr[1] = *(const u32x4*)(kp_ + 264); } \
    else { const size_t o_ = ((size_t)((b * 2 + l) * 256 + ((ci) - nloc) * 64 + skey)) * 256 + shead * 64 + sdq * 16; \
      _Pragma("unroll") for (int i_ = 0; i_ < 4; ++i_) { kr[i_] = *(const u32x4*)(P.cache_k + o_ + 4 * i_); vr[i_] = *(const u32x4*)(P.cache_v + o_ + 4 * i_); } } } while (0)
  float mrun = -1e30f, lrun = 0.f;
  f32x4 oacc[4];
#pragma unroll
  for (int i = 0; i < 4; ++i) oacc[i] = (f32x4){0.f, 0.f, 0.f, 0.f};
  const int w = qg * 16 + fr; const int cs = min(max(w - 8, 0), 48);
  AT_ISSUE(0);
  for (int ci = 0; ci < nchunks; ++ci) {
    const int buf = ci & 1;
    {
      u32x4 k0, k1, v0, v1;
      if (ci < nloc) { k0 = kr[0]; k1 = kr[1]; v0 = vr[0]; v1 = vr[1]; }
      else {
#define CV(a, i) pk2(__uint_as_float(a[i]), __uint_as_float(a[i + 1]))
        k0 = (u32x4){CV(kr[0], 0), CV(kr[0], 2), CV(kr[1], 0), CV(kr[1], 2)}; k1 = (u32x4){CV(kr[2], 0), CV(kr[2], 2), CV(kr[3], 0), CV(kr[3], 2)};
        v0 = (u32x4){CV(vr[0], 0), CV(vr[0], 2), CV(vr[1], 0), CV(vr[1], 2)}; v1 = (u32x4){CV(vr[2], 0), CV(vr[2], 2), CV(vr[3], 0), CV(vr[3], 2)};
#undef CV
      }
      unsigned char* kb = ldsK + (buf * 2 + sh) * 8192 + skey * 128; const int sw = (skey >> 1) & 7;
      *(u32x4*)(kb + (((2 * sdq) ^ sw) << 4)) = k0; *(u32x4*)(kb + (((2 * sdq + 1) ^ sw) << 4)) = k1;
      u16* vt = ldsV + (buf * 2 + sh) * (64 * 72) + (sdq * 16) * 72 + skey;
#pragma unroll
      for (int i = 0; i < 4; ++i) { vt[(2 * i) * 72] = (u16)(v0[i] & 0xffffu); vt[(2 * i + 1) * 72] = (u16)(v0[i] >> 16);
                                    vt[(8 + 2 * i) * 72] = (u16)(v1[i] & 0xffffu); vt[(8 + 2 * i + 1) * 72] = (u16)(v1[i] >> 16); }
    }
    __syncthreads();
    if (ci + 1 < nchunks) AT_ISSUE(ci + 1);
    const unsigned char* kb = ldsK + (buf * 2 + hh) * 8192;
    const u16* vb = ldsV + (buf * 2 + hh) * (64 * 72);
    f32x4 sacc[4];
#pragma unroll
    for (int kt = 0; kt < 4; ++kt) {
      sacc[kt] = (f32x4){0.f, 0.f, 0.f, 0.f};
#pragma unroll
      for (int ks = 0; ks < 2; ++ks) {
        const bf16x8 a = *(const bf16x8*)(kb + (kt * 16 + fr) * 128 + (((ks * 4 + fq) ^ ((fr >> 1) & 7)) << 4));
        sacc[kt] = __builtin_amdgcn_mfma_f32_16x16x32_bf16(a, qf[ks], sacc[kt], 0, 0, 0);
      }
    }
    float mx = -1e30f;
    if (type == 0 && ci < nloc) {
      const int dr = rs + ci - rq + 7;
      const float* bp = rpbL + hh * 465 + dr * 31;
#pragma unroll
      for (int kt = 0; kt < 4; ++kt)
#pragma unroll
        for (int j = 0; j < 4; ++j) {
          const int kc = kt * 16 + fq * 4 + j; const bool valid = (kc >= cs) && (kc < cs + 16);
          const int dc = min(max(kc - w + 15, 0), 30);
          const float sv = valid ? (sacc[kt][j] * 0.125f + bp[dc]) : -1e30f;
          sacc[kt][j] = sv; mx = fmaxf(mx, sv);
        }
    } else {
#pragma unroll
      for (int kt = 0; kt < 4; ++kt)
#pragma unroll
        for (int j = 0; j < 4; ++j) { const float sv = sacc[kt][j] * 0.125f; sacc[kt][j] = sv; mx = fmaxf(mx, sv); }
    }
    mx = fmaxf(mx, __shfl_xor(mx, 16)); mx = fmaxf(mx, __shfl_xor(mx, 32));
    const float mnew = fmaxf(mrun, mx); const float alpha = __expf(mrun - mnew);
    float ps = 0.f;
#pragma unroll
    for (int kt = 0; kt < 4; ++kt)
#pragma unroll
      for (int j = 0; j < 4; ++j) { const float pv = __expf(sacc[kt][j] - mnew); sacc[kt][j] = pv; ps += pv; }
    ps += __shfl_xor(ps, 16); ps += __shfl_xor(ps, 32);
    lrun = lrun * alpha + ps; mrun = mnew;
    bf16x8 pb[2];
#pragma unroll
    for (int k2 = 0; k2 < 2; ++k2) {
      u32x4 t; t.x = pk2(sacc[2 * k2][0], sacc[2 * k2][1]); t.y = pk2(sacc[2 * k2][2], sacc[2 * k2][3]);
      t.z = pk2(sacc[2 * k2 + 1][0], sacc[2 * k2 + 1][1]); t.w = pk2(sacc[2 * k2 + 1][2], sacc[2 * k2 + 1][3]);
      pb[k2] = __builtin_bit_cast(bf16x8, t);
    }
#pragma unroll
    for (int mt = 0; mt < 4; ++mt) {
      oacc[mt] = oacc[mt] * alpha;
#pragma unroll
      for (int k2 = 0; k2 < 2; ++k2) {
        const u16* vp = vb + (mt * 16 + fr) * 72 + (2 * k2) * 16 + fq * 4;
        const u32x2 lo = *(const u32x2*)vp, hi = *(const u32x2*)(vp + 16);
        const u32x4 av = {lo.x, lo.y, hi.x, hi.y};
        oacc[mt] = __builtin_amdgcn_mfma_f32_16x16x32_bf16(__builtin_bit_cast(bf16x8, av), pb[k2], oacc[mt], 0, 0, 0);
      }
    }
  }
  const float il = 1.0f / lrun;
#pragma unroll
  for (int mt = 0; mt < 4; ++mt) {
    u32x2 o; o.x = pk2(oacc[mt][0] * il, oacc[mt][1] * il); o.y = pk2(oacc[mt][2] * il, oacc[mt][3] * il);
    *(u32x2*)(P.H + (size_t)mq * 1024 + 768 + head * 64 + mt * 16 + fq * 4) = o;
  }
  __syncthreads();
#undef AT_ISSUE
}

#define NMIXJOBS 2080
DI void phase_mixer(const Params& P, int l, unsigned char* lds, volatile int* sjob) {
  for (;;) {
    __syncthreads();
    if (threadIdx.x == 0) *sjob = (int)atomicAdd(P.qctr + l, 1u);
    __syncthreads();
    const int job = *sjob;
    if (job >= NMIXJOBS) break;
    int kind, a0, a1, a2, a3 = 0;
    if (job < 64) { const int u = job; kind = 0; a0 = 32 + (u >> 3); a1 = (u >> 1) & 3; a2 = u & 1; }
    else if (job < 128) { const int u = job - 64; kind = 1; a0 = 32 + (u >> 3); a1 = (u >> 1) & 3; a2 = u & 1; }
    else if (job < 160) { const int u = job - 128; kind = 2; a0 = 32 + (u >> 2); a1 = (u >> 1) & 1; a2 = u & 1; }
    else if (job < 416) { const int u = job - 160; kind = 0; a0 = u >> 3; a1 = (u >> 1) & 3; a2 = u & 1; }
    else if (job < 672) { const int u = job - 416; kind = 1; a0 = u >> 3; a1 = (u >> 1) & 3; a2 = u & 1; }
    else if (job < 800) { const int u = job - 672; kind = 2; a0 = u >> 2; a1 = (u >> 1) & 1; a2 = u & 1; }
    else if (job < 1824) { const int u = job - 800; kind = 3; a0 = u >> 7; a1 = (u >> 1) & 63; a2 = u & 1; a3 = 0; }
    else { const int u = job - 1824; kind = 3; a0 = u >> 3; a1 = (u >> 1) & 3; a2 = u & 1; a3 = 1; }
    if (kind == 0) rwkv_unit(P, l, a0, a1, a2, lds);
    else if (kind == 1) hgrn_unit(P, l, a0, a1, a2, lds);
    else if (kind == 2) s5_block(P, l, a0, a1, a2, lds);
    else attn_job(P, l, a3, a0, a1, a2, lds);
  }
}

DI void phase_final(const Params& P, int l, unsigned char* lds) {
  float* sgT = (float*)lds;
  float* glT = sgT + 128 * 32;
  float* oaT = glT + 256 * 32;
  const int tid = ltid(); const int c = tid & 255, hf = tid >> 8;
  const u16* pA = P.R1; const u16* pB = P.R1 + (size_t)MTOK * 1024; const u16* pC = P.R1 + (size_t)MTOK * 1280;
  float mup[3], mun[3];
#pragma unroll
  for (int k = 0; k < 3; ++k) { mup[k] = P.rw_mu[(size_t)(l * 2 + 0) * 1024 + k * 256 + c]; mun[k] = P.rw_mu[(size_t)(l * 2 + 1) * 1024 + k * 256 + c]; }
  const float k_a = P.rw_k_a[l * 256 + c], r_k = P.rw_r_k[l * 256 + c], lnxg = P.rw_lnx_g[l * 256 + c], lnxb = P.rw_lnx_b[l * 256 + c];
  const float s5d = P.s5_d[l * 256 + c], glub = P.s5_glu_b[l * 256 + c], hgg = P.hg_norm_g[l * 256 + c];
  for (int job = blockIdx.x; job < MTOK / 32; job += gridDim.x) {
    const int m0 = job * 32;
    int start, len; { const int s = m0 < NCTX ? (m0 >> 8) : 32 + ((m0 - NCTX) >> 12); seq_info(s, start, len); }
    {
      const int t = tid >> 4, cg = tid & 15; const int m = m0 + t, tt = m - start; const int col = 896 + cg * 8;
      const u16* p0 = pA + (size_t)m * 1024 + col;
      u32x4 cc = *(const u32x4*)p0, pv = {0, 0, 0, 0}, nx = {0, 0, 0, 0};
      if (tt > 0) pv = *(const u32x4*)(p0 - 1024);
      if (tt < len - 1) nx = *(const u32x4*)(p0 + 1024);
#pragma unroll
      for (int i = 0; i < 8; ++i) {
        const unsigned cw = cc[i >> 1], pw = pv[i >> 1], nw = nx[i >> 1];
        const float x = (i & 1) ? bfhi(cw) : bflo(cw), xp = (i & 1) ? bfhi(pw) : bflo(pw), xn = (i & 1) ? bfhi(nw) : bflo(nw);
        const float sh = x + P.rw_mu[(size_t)(l * 2 + 0) * 1024 + col + i] * (xp - x) + P.rw_mu[(size_t)(l * 2 + 1) * 1024 + col + i] * (xn - x);
        sgT[(cg * 8 + i) * 32 + t] = sigmoidf_(sh);
      }
    }
#pragma unroll 1
    for (int t = 0; t < 16; ++t) {
      const int m = m0 + hf * 16 + t, tt = m - start;
      const float y = bf2f(P.H[(size_t)m * 1024 + c]) + bf2f(P.YB[(size_t)m * 256 + c]);
      const float mean = wave_sum(y) * (1.0f / 64.0f); const float dy = y - mean;
      const float var = wave_sum(dy * dy) * (1.0f / 64.0f);
      const float yn = dy * (1.0f / sqrtf(var + 64e-5f)) * lnxg + lnxb;
      float sh[3];
#pragma unroll
      for (int k = 0; k < 3; ++k) {
        const u16* p0 = pA + (size_t)m * 1024 + k * 256 + c;
        const float x = bf2f(*p0), xp = (tt > 0) ? bf2f(*(p0 - 1024)) : 0.f, xn = (tt < len - 1) ? bf2f(*(p0 + 1024)) : 0.f;
        sh[k] = x + mup[k] * (xp - x) + mun[k] * (xn - x);
      }
      const float a = bf2f(P.PA[(size_t)m * 256 + c]);
      const float keff = sh[1] * (1.f + (a - 1.f) * k_a);
      const float bsum = wave_sum(sh[0] * keff * r_k);
      oaT[c * 32 + hf * 16 + t] = yn + bsum * sh[2];
      const float ys = bf2f(P.H[(size_t)m * 1024 + 256 + c]) + bf2f(P.YB[(size_t)(MTOK + m) * 256 + c]) + s5d * bf2f(pB[(size_t)m * 256 + c]);
      const float g3 = 0.7978845608f * (ys + 0.044715f * ys * ys * ys);
      const float gl = 0.5f * ys * (1.0f + tanhf(g3));
      glT[c * 32 + hf * 16 + t] = gl;
      const float o = bf2f(P.H[(size_t)m * 1024 + 512 + c]) + bf2f(P.YB[(size_t)(2 * MTOK + m) * 256 + c]);
      const float ms = wave_sum(o * o) * (1.0f / 64.0f);
      const float gt = bf2f(pC[(size_t)m * 1280 + 1024 + c]);
      P.H[(size_t)m * 1024 + 512 + c] = f2bf(o * (1.0f / sqrtf(ms + 1e-5f)) * hgg * siluf_(gt));
    }
    __syncthreads();
    {
      float gg[16];
#pragma unroll
      for (int t = 0; t < 16; ++t) gg[t] = 0.f;
      const float* wg = P.rw_g_up + (size_t)l * 128 * 256 + c;
      for (int j = 0; j < 128; ++j) {
        const float w = wg[j * 256]; const f32x4* sp = (const f32x4*)(sgT + j * 32 + hf * 16);
#pragma unroll
        for (int q = 0; q < 4; ++q) { const f32x4 sv = sp[q];
#pragma unroll
          for (int i = 0; i < 4; ++i) gg[q * 4 + i] += sv[i] * w; }
      }
#pragma unroll
      for (int t = 0; t < 16; ++t) P.H[(size_t)(m0 + hf * 16 + t) * 1024 + c] = f2bf(oaT[c * 32 + hf * 16 + t] * gg[t]);
    }
    {
      float ga[16];
#pragma unroll
      for (int t = 0; t < 16; ++t) ga[t] = glub;
      const float* wg = P.s5_glu_w + (size_t)l * 256 * 256 + c;
      for (int j = 0; j < 256; ++j) {
        const float w = wg[j * 256]; const f32x4* sp = (const f32x4*)(glT + j * 32 + hf * 16);
#pragma unroll
        for (int q = 0; q < 4; ++q) { const f32x4 sv = sp[q];
#pragma unroll
          for (int i = 0; i < 4; ++i) ga[q * 4 + i] += sv[i] * w; }
      }
#pragma unroll
      for (int t = 0; t < 16; ++t) P.H[(size_t)(m0 + hf * 16 + t) * 1024 + 256 + c] = f2bf(glT[c * 32 + hf * 16 + t] * sigmoidf_(ga[t]));
    }
    __syncthreads();
  }
}

#define NPHASES 26
DI void run_phase(const Params& P, int ph, unsigned char* lds, volatile int* sjob) {
  PG8_LAS unsigned char* ldsa = (PG8_LAS unsigned char*)lds;
  if (ph == 0) { phase_p0(P, lds); return; }
  if (ph == 25) { phase_lnmod(P, P.ln_g + (size_t)(1 * 3 + 2) * 1024, P.ln_b + (size_t)(1 * 3 + 2) * 1024, nullptr, 0, 0); return; }
  const int l = (ph - 1) / 12, sp = (ph - 1) % 12;
  const float* modl = P.mod + (size_t)l * 9 * 9216;
  const float* lng = P.ln_g + (size_t)l * 3 * 1024; const float* lnb = P.ln_b + (size_t)l * 3 * 1024;
  switch (sp) {
    case 0:
      if (l == 0) phase_lnmod(P, nullptr, nullptr, modl, 0, 1);
      else {
        float* tl = (float*)lds;
        for (int job = blockIdx.x; job < NCONV; job += gridDim.x) convert_job(P, 1, job, tl);
        phase_lnmod(P, P.ln_g + (size_t)(0 * 3 + 2) * 1024, P.ln_b + (size_t)(0 * 3 + 2) * 1024, modl, 0, 0);
      }
      break;
    case 1: { EpiSwiglu E; E.O = P.R1; run_gemm(ldsa, P.H, P.WA0, MTOK, 5632, 1024, E); } break;
    case 2: { EpiResid E; E.xp = P.x_prompt; E.xs = P.x_sample; E.X = P.X; E.gate = modl + 2 * 1024; E.gs = 0.5f; E.from_input = (l == 0); run_gemm(ldsa, P.R1, P.WB0, MTOK, 1024, DFF, E); } break;
    case 3: phase_lnmod(P, lng, lnb, modl, 3, 0); break;
    case 4: { EpiP E; E.R1 = P.R1; E.nak = P.o_nak; E.nav = P.o_nav; E.l = l; run_gemm(ldsa, P.H, P.WC, MTOK, 3328, 1024, E); } break;
    case 5: phase_prep(P, l, lds); break;
    case 6: phase_mixer(P, l, lds, sjob); break;
    case 7: phase_final(P, l, lds); break;
    case 8: { EpiResid E; E.xp = P.x_prompt; E.xs = P.x_sample; E.X = P.X; E.gate = modl + 5 * 1024; E.gs = 1.0f; E.from_input = 0; run_gemm(ldsa, P.H, P.WD, MTOK, 1024, 1024, E); } break;
    case 9: phase_lnmod(P, lng + 1024, lnb + 1024, modl, 6, 0); break;
    case 10: { EpiSwiglu E; E.O = P.R1; run_gemm(ldsa, P.H, P.WA1, MTOK, 5632, 1024, E); } break;
    case 11: { EpiResid E; E.xp = P.x_prompt; E.xs = P.x_sample; E.X = P.X; E.gate = modl + 8 * 1024; E.gs = 0.5f; E.from_input = 0; run_gemm(ldsa, P.R1, P.WB1, MTOK, 1024, DFF, E); } break;
  }
}

extern __shared__ __attribute__((aligned(16))) unsigned char dyn_lds[];

__global__ __launch_bounds__(NTHR, 2) void k_mega(Params P) {
  __shared__ int sjob_s[4];
  cg::grid_group grid = cg::this_grid();
#pragma unroll 1
  for (int ph = 0; ph < NPHASES; ++ph) {
    run_phase(P, ph, dyn_lds, sjob_s);
    if (ph + 1 < NPHASES) grid.sync();
  }
}
__global__ __launch_bounds__(NTHR, 2) void k_one(Params P, int ph) {
  __shared__ int sjob_s[4];
  run_phase(P, ph, dyn_lds, sjob_s);
}

#define LDS_BYTES 131072

extern "C" void kernel_launch(void* const* d_in, const int* in_sizes, int n_in, void* d_out, int out_size, void* d_ws, size_t ws_size, hipStream_t stream) {
  Params P{};
  const float* const* in = (const float* const*)d_in;
  P.x_prompt = in[0]; P.x_sample = in[1]; P.cache_k = in[2]; P.cache_v = in[3]; P.st_rwkv = in[4]; P.st_s5 = in[5]; P.st_hgrn = in[6]; P.c = in[7]; P.c_ctx = in[8];
  P.w_mod = in[9]; P.b_mod = in[10]; P.ln_g = in[11]; P.ln_b = in[12]; P.ffn_w_in = in[13]; P.ffn_w_out = in[14]; P.w_in = in[15]; P.w_out = in[16];
  P.rw_mu = in[17]; P.rw_w0 = in[18]; P.rw_w_up = in[19]; P.rw_a0 = in[20]; P.rw_a_up = in[21]; P.rw_g_up = in[22]; P.rw_k_k = in[23]; P.rw_k_a = in[24]; P.rw_r_k = in[25];
  P.rw_lnx_g = in[26]; P.rw_lnx_b = in[27];
  P.s5_a_re = in[28]; P.s5_a_im = in[29]; P.s5_log_dt = in[30]; P.s5_b_re = in[31]; P.s5_b_im = in[32]; P.s5_c_re = in[33]; P.s5_c_im = in[34]; P.s5_d = in[35];
  P.s5_glu_w = in[36]; P.s5_glu_b = in[37]; P.hg_lb = in[38]; P.hg_norm_g = in[39]; P.na_rpb = in[40];
  float* out = (float*)d_out;
  P.X = out; size_t o = (size_t)MTOK * 1024;
  P.o_nak = out + o; o += (size_t)32 * 2 * 256 * 256;
  P.o_nav = out + o; o += (size_t)32 * 2 * 256 * 256;
  P.o_rwkv = out + o; o += (size_t)32 * 2 * 2 * 4 * 4096;
  P.o_s5 = out + o; o += (size_t)32 * 2 * 2 * 16 * 128;
  P.o_hgrn = out + o;
  unsigned char* w = (unsigned char*)d_ws; size_t off = 0;
  auto take = [&](size_t bytes) { unsigned char* p = w + off; off += (bytes + 255) & ~(size_t)255; return p; };
  P.qctr = (unsigned*)take(256);
  P.mod = (float*)take((size_t)2 * 9 * 9216 * 4);
  P.WA0 = (u16*)take((size_t)5632 * 1024 * 2); P.WA1 = (u16*)take((size_t)5632 * 1024 * 2);
  P.WB0 = (u16*)take((size_t)1024 * DFF * 2); P.WB1 = (u16*)take((size_t)1024 * DFF * 2);
  P.WC = (u16*)take((size_t)3328 * 1024 * 2); P.WD = (u16*)take((size_t)1024 * 1024 * 2);
  P.R1 = (u16*)take((size_t)MTOK * 3328 * 2);
  P.H = (u16*)take((size_t)MTOK * 1024 * 2);
  P.PA = (u16*)take((size_t)MTOK * 256 * 2); P.PE0 = (u16*)take((size_t)MTOK * 256 * 2); P.PE1 = (u16*)take((size_t)MTOK * 256 * 2);
  P.YB = (u16*)take((size_t)MTOK * 768 * 2);
  if (off > ws_size) fprintf(stderr, "workspace too small: need %zu have %zu\n", off, ws_size);
  static int configured = 0;
  if (!configured) {
    hipFuncSetAttribute((const void*)k_mega, hipFuncAttributeMaxDynamicSharedMemorySize, LDS_BYTES);
    hipFuncSetAttribute((const void*)k_one, hipFuncAttributeMaxDynamicSharedMemorySize, LDS_BYTES);
    configured = 1;
  }
#if MEGA
  void* args[] = {&P};
  hipError_t e = hipLaunchCooperativeKernel((const void*)k_mega, dim3(256), dim3(NTHR), args, LDS_BYTES, stream);
  if (e != hipSuccess) fprintf(stderr, "cooperative launch failed: %s\n", hipGetErrorString(e));
#else
  for (int ph = 0; ph < NPHASES; ++ph) k_one<<<dim3(256), dim3(NTHR), LDS_BYTES, stream>>>(P, ph);
#endif
}
```

```cpp
#include <hip/hip_runtime.h>
#include <hip/hip_cooperative_groups.h>
#include <stdint.h>
#include <cstdio>
namespace cg = cooperative_groups;

#ifndef MEGA
#define MEGA 1
#endif

typedef unsigned short u16;
typedef short bf16x8 __attribute__((ext_vector_type(8)));
typedef float f32x4 __attribute__((ext_vector_type(4)));
typedef unsigned u32x4 __attribute__((ext_vector_type(4)));
typedef unsigned u32x2 __attribute__((ext_vector_type(2)));

#define NCTX 8192
#define MTOK 40960
#define DFF 2816
#define ALPHA_F 1.41421356237f
#define NTHR 512

struct Params {
  const float *x_prompt, *x_sample, *cache_k, *cache_v, *st_rwkv, *st_s5, *st_hgrn, *c, *c_ctx;
  const float *w_mod, *b_mod, *ln_g, *ln_b, *ffn_w_in, *ffn_w_out, *w_in, *w_out;
  const float *rw_mu, *rw_w0, *rw_w_up, *rw_a0, *rw_a_up, *rw_g_up, *rw_k_k, *rw_k_a, *rw_r_k, *rw_lnx_g, *rw_lnx_b;
  const float *s5_a_re, *s5_a_im, *s5_log_dt, *s5_b_re, *s5_b_im, *s5_c_re, *s5_c_im, *s5_d, *s5_glu_w, *s5_glu_b;
  const float *hg_lb, *hg_norm_g, *na_rpb;
  float *X, *o_nak, *o_nav, *o_rwkv, *o_s5, *o_hgrn;
  u16 *WA0, *WA1, *WB0, *WB1, *WC, *WD;
  u16 *WGLU, *WGUP, *WAUP, *WWUP0, *WWUP1;
  u16 *R1, *H, *PA, *PE0, *PE1, *YB;
  u16 *KC, *VC;
  float* mod;
  float* ST;
  unsigned* qctr;
  unsigned* bar;
};

#define DI __device__ __forceinline__

DI u16 f2bf(float f) { unsigned u = __float_as_uint(f); u += 0x7fffu + ((u >> 16) & 1u); return (u16)(u >> 16); }
DI float bf2f(u16 h) { return __uint_as_float(((unsigned)h) << 16); }
DI float bflo(unsigned w) { return __uint_as_float(w << 16); }
DI float bfhi(unsigned w) { return __uint_as_float(w & 0xffff0000u); }
DI unsigned pk2(float lo, float hi) { return (unsigned)f2bf(lo) | ((unsigned)f2bf(hi) << 16); }
DI float sigmoidf_(float x) { return 1.0f / (1.0f + __expf(-x)); }
DI float siluf_(float x) { return x / (1.0f + __expf(-x)); }
DI float wave_sum(float v) {
#pragma unroll
  for (int o = 32; o >= 1; o >>= 1) v += __shfl_xor(v, o);
  return v;
}
template <int CTRL> DI float dppf(float x) { return __builtin_bit_cast(float, __builtin_amdgcn_update_dpp(0, __builtin_bit_cast(int, x), CTRL, 0xF, 0xF, true)); }
DI float red8(float x) { x += dppf<0xB1>(x); x += dppf<0x4E>(x); x += dppf<0x141>(x); return x; }
typedef float f32x2 __attribute__((ext_vector_type(2)));
DI f32x2 lo2(f32x4 v) { return (f32x2){v[0], v[1]}; }
DI f32x2 hi2(f32x4 v) { return (f32x2){v[2], v[3]}; }
DI float red16(float x) { x += dppf<0xB1>(x); x += dppf<0x4E>(x); x += dppf<0x141>(x); x += dppf<0x140>(x); return x; }
DI float hsum32(float x) { x += dppf<0xB1>(x); x += dppf<0x4E>(x); x += dppf<0x141>(x); x += dppf<0x140>(x); x += __shfl_xor(x, 16); return x; }
DI int ltid() { int t = threadIdx.x; asm volatile("" : "+v"(t)); return t; }
DI int mrow_of(int m) { return m < NCTX ? 0 : 1 + ((m - NCTX) >> 12); }
DI void seq_info(int s, int& start, int& len) { if (s < 32) { start = s * 256; len = 256; } else { start = NCTX + (s - 32) * 4096; len = 4096; } }

#define XB_TMO      128
#define XB_XCNT(j)  (256  + 64 * (j))
#define XB_XSUB(j)  (1280 + 64 * (j))
#define XB_XGEN(j)  (2304 + 64 * (j))
#define XB_TOP      3328
#define XB_TOPGEN   3392
#define XCD_BAR_WORDS 3456
#define XB_SPIN_CAP (1u << 18)
#define LAS __attribute__((address_space(3)))

__device__ __forceinline__ unsigned xb_ld(unsigned* p)              { return __hip_atomic_load(p, __ATOMIC_RELAXED, __HIP_MEMORY_SCOPE_AGENT); }
__device__ __forceinline__ unsigned xb_add(unsigned* p, unsigned v) { return __hip_atomic_fetch_add(p, v, __ATOMIC_RELAXED, __HIP_MEMORY_SCOPE_AGENT); }
__device__ __forceinline__ unsigned xb_xcc_id() { return (unsigned)__builtin_amdgcn_s_getreg((3 << 11) | 20) & 0xFu; }
#define XB_SPIN(cond, bar) do { unsigned _sp = 0; while (cond) { __builtin_amdgcn_s_sleep(1); \
    if ((++_sp & 255u) == 0u) { if (xb_ld(&(bar)[XB_TMO])) break; if (_sp > XB_SPIN_CAP) { atomicAdd(&(bar)[XB_TMO], 1u); break; } } } } while (0)

struct XcdBarrier {
    unsigned* bar; unsigned x;
    volatile LAS unsigned* st;
};

__device__ __forceinline__ XcdBarrier xcd_barrier_post(unsigned* bar, volatile LAS unsigned* st) {
    XcdBarrier b; b.bar = bar; b.x = xb_xcc_id(); b.st = st;
    if (threadIdx.x == 0) (void)xb_add(&bar[XB_XCNT(b.x)], 1u);
    return b;
}
__device__ __forceinline__ void xcd_barrier_complete(unsigned* bar, unsigned x, unsigned& nloc, unsigned& nx) {
    const unsigned G = gridDim.x * gridDim.y * gridDim.z;
    unsigned sum, cnt, mine, sp = 0u;
    for (;;) {
        sum = 0u; cnt = 0u; mine = 0u;
#pragma unroll
        for (unsigned j = 0; j < 16; ++j) { const unsigned c = xb_ld(&bar[XB_XCNT(j)]); sum += c; cnt += (c > 0u) ? 1u : 0u; mine = (j == x) ? c : mine; }
        if (sum == G) break;
        __builtin_amdgcn_s_sleep(1);
        if ((++sp & 255u) == 0u) { if (xb_ld(&bar[XB_TMO])) break; if (sp > XB_SPIN_CAP) { atomicAdd(&bar[XB_TMO], 1u); break; } }
    }
    nloc = mine > 0u ? mine : 1u; nx = cnt > 0u ? cnt : 1u;
}

__device__ __forceinline__ void xcd_barrier(const XcdBarrier& b) {
    asm volatile("s_waitcnt vmcnt(0)" ::: "memory");
    __syncthreads();
    if (threadIdx.x == 0) {
        unsigned* bar = b.bar;
        __builtin_amdgcn_s_waitcnt(0);
        unsigned nloc = b.st[0], nx = b.st[1];
        if (nloc == 0u) { xcd_barrier_complete(bar, b.x, nloc, nx); b.st[0] = nloc; b.st[1] = nx; }
        const unsigned old = xb_add(&bar[XB_XSUB(b.x)], 1u);
        const unsigned gen = old / nloc;
        if (old + 1u == (gen + 1u) * nloc) {
            __builtin_amdgcn_fence(__ATOMIC_RELEASE, "agent");
            asm volatile("s_waitcnt vmcnt(0)" ::: "memory");
            const unsigned og = xb_add(&bar[XB_TOP], 1u);
            const unsigned tg = og / nx;
            if (og + 1u == (tg + 1u) * nx) xb_add(&bar[XB_TOPGEN], 1u);
            else XB_SPIN(xb_ld(&bar[XB_TOPGEN]) == tg, bar);
            __builtin_amdgcn_fence(__ATOMIC_ACQUIRE, "agent");
            xb_add(&bar[XB_XGEN(b.x)], 1u);
            asm volatile("s_waitcnt vmcnt(0)" ::: "memory");
        } else {
            XB_SPIN(xb_ld(&bar[XB_XGEN(b.x)]) == gen, bar);
            __builtin_amdgcn_fence(__ATOMIC_ACQUIRE, "agent");
            asm volatile("s_waitcnt vmcnt(0)" ::: "memory");
        }
    }
    __syncthreads();
}

namespace pg8 {
#define PG8_LAS __attribute__((address_space(3)))
typedef unsigned short bf16_t;
typedef short bf16x8 __attribute__((ext_vector_type(8)));
typedef float f32x4 __attribute__((ext_vector_type(4)));
typedef unsigned u32x4 __attribute__((ext_vector_type(4)));
constexpr int BM = 256, BK = 64, HALF = 128, HTB = HALF * BK * 2  , STAGE_BYTES = 8 * HTB, NXCD = 8, WGM = 8;

__host__ __device__ __forceinline__ int lds_byte(int r, int c) { const int st = (r >> 4) * 2 + (c >> 5), rr = r & 15, cc = c & 31, ob = rr * 64 + cc * 2; return st * 1024 + (ob ^ (((ob >> 9) & 1) << 5)); }
__host__ __device__ __forceinline__ void stage_rc(int b, int& R, int& C) { const int st = b / 1024, sb = b % 1024, swz = sb ^ (((sb >> 9) & 1) << 5); R = (st >> 1) * 16 + swz / 64; C = (st & 1) * 32 + (swz % 64) / 2; }
__host__ __device__ __forceinline__ int perm32(int rho) { const int n = rho >> 4, i = rho & 15; return 8 * (i >> 2) + 4 * n + (i & 3); }

struct Unit { int pm, pn; };
struct Gemm { const bf16_t* A; const bf16_t* Bt; int M, N, K; };

struct StaticOrder {
    int nM, nN, nwg, G, c;
    __host__ __device__ void init(int M, int N, int G_, int c_) { nM = M / BM; nN = N / BM; nwg = nM * nN; G = G_; c = c_; }
    __host__ __device__ bool next(int i, Unit& u) const {
        const long L = (long)i * G + c; if (L >= nwg) return false;
        int wgid = (int)L; { const int q = nwg / NXCD, r = nwg % NXCD, xcd = wgid % NXCD, off = wgid / NXCD; wgid = (xcd < r ? xcd * (q + 1) : r * (q + 1) + (xcd - r) * q) + off; }
        const int nig = WGM * nN, gid = wgid / nig, fm = gid * WGM, gsz = (nM - fm) < WGM ? (nM - fm) : WGM;
        u.pm = fm + ((wgid % nig) % gsz); u.pn = (wgid % nig) / gsz; return true;
    }
    __device__ __forceinline__ void a_ready(const Unit&) const {}
    __device__ __forceinline__ void done(const Unit&) const {}
};
__device__ __forceinline__ unsigned cvt_pk_bf16(float lo, float hi) { unsigned r; asm volatile("v_cvt_pk_bf16_f32 %0, %1, %2" : "=v"(r) : "v"(lo), "v"(hi)); return r; }
template <class Epi, class Sched, bool STAMP = false>
__device__ __forceinline__ void gemm_phase(PG8_LAS unsigned char* lds, const Gemm g, const Sched& S, const Epi& E, unsigned long long* stamps) {
    int tid = threadIdx.x; asm volatile("" : "+v"(tid)); const int wid = __builtin_amdgcn_readfirstlane(tid >> 6), lane = tid & 63, wr = wid >> 2, wc = wid & 3, fr = lane & 15, fq = lane >> 4;
    const int K = g.K, nt = K / BK;
    int ts_lo = 0, ts_hi = 0, nts = 0; const unsigned long long rt_entry = STAMP ? (unsigned long long)wall_clock64() : 0ull;
#define PG8_STAMP() do { if (STAMP && wid == 0 && nts < 64) { const unsigned long long _c = (unsigned long long)clock64(); \
        ts_lo = (lane == nts) ? (int)(unsigned)_c : ts_lo; ts_hi = (lane == nts) ? (int)(unsigned)(_c >> 32) : ts_hi; ++nts; } } while (0)
    PG8_STAMP();
    unsigned voffA[2], voffB[2];
#pragma unroll
    for (int i = 0; i < 2; ++i) { int R, C; stage_rc(tid * 16 + i * 8192, R, C); const int Rb = Epi::PERM ? ((R & ~31) + perm32(R & 31)) : R;
        voffA[i] = (unsigned)(R * K + C) * 2u; voffB[i] = (unsigned)(Rb * K + C) * 2u; }
    const size_t kstep = (size_t)(BK * 2);
    const size_t hstep = (size_t)HALF * K * 2;
    const size_t tstep = 2 * hstep;
    const unsigned ldsw = (unsigned)wid * 1024u;
    const int aoff = lds_byte(wr * 64 + fr, fq * 8), boff = lds_byte(wc * 32 + fr, fq * 8);
#define PG8_SA(b, h) (((b) * 2 + (h)) * HTB)
#define PG8_SB(b, h) ((4 + (b) * 2 + (h)) * HTB)
#define PG8_STAGE(bufoff, gbase, voff) do { _Pragma("unroll") for (int _i = 0; _i < 2; ++_i) \
        __builtin_amdgcn_global_load_lds((const unsigned*)((const char*)(gbase) + (voff)[_i]), (PG8_LAS unsigned*)(lds + (bufoff) + ldsw + _i * 8192), 16, 0, 0); } while (0)
#define PG8_LDA(dst, b, h) do { _Pragma("unroll") for (int m = 0; m < 4; ++m) _Pragma("unroll") for (int k = 0; k < 2; ++k) dst[m][k] = *(const PG8_LAS bf16x8*)(lds + PG8_SA(b, h) + aoff + m * 2048 + k * 1024); } while (0)
#define PG8_LDB(dst, b, h) do { _Pragma("unroll") for (int n = 0; n < 2; ++n) _Pragma("unroll") for (int k = 0; k < 2; ++k) dst[n][k] = *(const PG8_LAS bf16x8*)(lds + PG8_SB(b, h) + boff + n * 2048 + k * 1024); } while (0)
#define PG8_MMA(ai, bj, At, Bt) do { __builtin_amdgcn_s_setprio(1); _Pragma("unroll") for (int m = 0; m < 4; ++m) _Pragma("unroll") for (int n = 0; n < 2; ++n) _Pragma("unroll") for (int k = 0; k < 2; ++k) \
        acc[ai][bj][m][n] = __builtin_amdgcn_mfma_f32_16x16x32_bf16(Bt[n][k], At[m][k], acc[ai][bj][m][n], 0, 0, 0); __builtin_amdgcn_s_setprio(0); } while (0)
#define PG8_WAIT_V(n) asm volatile("s_waitcnt vmcnt(" #n ")" ::: "memory")
#define PG8_WAIT_L(n) asm volatile("s_waitcnt lgkmcnt(" #n ")" ::: "memory")
#define PG8_BAR __builtin_amdgcn_s_barrier()
#define PG8_SCHED __builtin_amdgcn_sched_barrier(0)
    Unit cur, nxt; int ui = 0;
    if (!S.next(0, cur)) return;
    f32x4 acc[2][2][4][2];
#pragma unroll
    for (int a = 0; a < 2; ++a)
#pragma unroll
        for (int b = 0; b < 2; ++b)
#pragma unroll
            for (int m = 0; m < 4; ++m)
#pragma unroll
                for (int n = 0; n < 2; ++n) acc[a][b][m][n] = (f32x4){0.f, 0.f, 0.f, 0.f};
    bf16x8 At[4][2], B0[2][2], B1[2][2];
    const char* cA = (const char*)g.A + (size_t)cur.pm * tstep; const char* cB = (const char*)g.Bt + (size_t)cur.pn * tstep;
    S.a_ready(cur);
    PG8_STAGE(PG8_SB(0, 0), cB, voffB); PG8_STAGE(PG8_SA(0, 0), cA, voffA); PG8_STAGE(PG8_SB(0, 1), cB + hstep, voffB); PG8_STAGE(PG8_SA(0, 1), cA + hstep, voffA);
    if (wr == 1) PG8_BAR;
    PG8_WAIT_V(4); PG8_BAR;
    PG8_STAGE(PG8_SB(1, 0), cB + kstep, voffB); PG8_STAGE(PG8_SA(1, 0), cA + kstep, voffA); PG8_STAGE(PG8_SB(1, 1), cB + hstep + kstep, voffB);
    PG8_WAIT_V(6); PG8_BAR;
    PG8_STAMP();
    for (;;) {
        const bool has_next = S.next(ui + 1, nxt);
        const char* nA = has_next ? (const char*)g.A + (size_t)nxt.pm * tstep : cA; const char* nB = has_next ? (const char*)g.Bt + (size_t)nxt.pn * tstep : cB;
        for (int t = 0; t < nt; t += 2) {
            const bool last = (t == nt - 2);
            const char* a1 = cA + (size_t)(t + 1) * kstep;
            const char* a2 = last ? nA : cA + (size_t)(t + 2) * kstep; const char* b2 = last ? nB : cB + (size_t)(t + 2) * kstep;
            const char* a3 = a2 + kstep; const char* b3 = b2 + kstep;
            if (last && has_next) S.a_ready(nxt);
            PG8_LDB(B0, 0, 0); PG8_SCHED; PG8_LDA(At, 0, 0); PG8_STAGE(PG8_SA(1, 1), a1 + hstep, voffA);
            PG8_WAIT_L(8); PG8_BAR; PG8_WAIT_L(0); PG8_MMA(0, 0, At, B0); PG8_BAR; PG8_SCHED;
            PG8_LDB(B1, 0, 1); PG8_STAGE(PG8_SB(0, 0), b2, voffB);
            PG8_BAR; PG8_WAIT_L(0); PG8_MMA(0, 1, At, B1); PG8_BAR;
            PG8_LDA(At, 0, 1); PG8_STAGE(PG8_SA(0, 0), a2, voffA);
            PG8_BAR; PG8_WAIT_L(0); PG8_MMA(1, 0, At, B0); PG8_BAR; PG8_SCHED;
            PG8_STAGE(PG8_SB(0, 1), b2 + hstep, voffB);
            PG8_WAIT_V(6); PG8_BAR; PG8_MMA(1, 1, At, B1); PG8_BAR;
            PG8_LDB(B0, 1, 0); PG8_SCHED; PG8_LDA(At, 1, 0); PG8_STAGE(PG8_SA(0, 1), a2 + hstep, voffA);
            PG8_WAIT_L(8); PG8_BAR; PG8_WAIT_L(0); PG8_MMA(0, 0, At, B0); PG8_BAR; PG8_SCHED;
            PG8_LDB(B1, 1, 1); PG8_STAGE(PG8_SB(1, 0), b3, voffB);
            PG8_BAR; PG8_WAIT_L(0); PG8_MMA(0, 1, At, B1); PG8_BAR;
            PG8_LDA(At, 1, 1); PG8_STAGE(PG8_SA(1, 0), a3, voffA);
            PG8_BAR; PG8_WAIT_L(0); PG8_MMA(1, 0, At, B0); PG8_BAR; PG8_SCHED;
            PG8_STAGE(PG8_SB(1, 1), b3 + hstep, voffB);
            PG8_WAIT_V(6); PG8_BAR; PG8_MMA(1, 1, At, B1); PG8_BAR;
        }
        PG8_STAMP();
        if constexpr (!Epi::AFTER_DRAIN) { E(acc, cur, wr, wc, fr, fq); S.done(cur); }
        PG8_STAMP();
        if (!has_next) break;
#pragma unroll
        for (int a = 0; a < 2; ++a)
#pragma unroll
            for (int b = 0; b < 2; ++b)
#pragma unroll
                for (int m = 0; m < 4; ++m)
#pragma unroll
                    for (int n = 0; n < 2; ++n) acc[a][b][m][n] = (f32x4){0.f, 0.f, 0.f, 0.f};
        cur = nxt; cA = nA; cB = nB; ++ui;
    }
    PG8_WAIT_V(0);
    if (wr == 0) PG8_BAR;
    PG8_BAR;
    if constexpr (Epi::AFTER_DRAIN) { E.fused(acc, cur, wr, wc, fr, fq, lds, wid, lane); S.done(cur); }
    PG8_STAMP();
    if (STAMP && wid == 0) { stamps[lane] = lane < nts ? (((unsigned long long)(unsigned)ts_hi << 32) | (unsigned)ts_lo) : 0ull;
        if (lane == 62) stamps[62] = rt_entry; if (lane == 63) stamps[63] = (unsigned long long)wall_clock64(); }
#undef PG8_STAMP
#undef PG8_SA
#undef PG8_SB
#undef PG8_STAGE
#undef PG8_LDA
#undef PG8_LDB
#undef PG8_MMA
#undef PG8_WAIT_V
#undef PG8_WAIT_L
#undef PG8_BAR
#undef PG8_SCHED
}
}

struct EpiSwiglu {
  static constexpr bool PERM = true, AFTER_DRAIN = false;
  u16* O;
  DI void operator()(const f32x4 (&acc)[2][2][4][2], const pg8::Unit& u, int wr, int wc, int fr, int fq) const {
    const int row0 = u.pm * 256 + wr * 64 + fr, col0 = u.pn * 128 + wc * 32 + 8 * fq;
#pragma unroll
    for (int ai = 0; ai < 2; ++ai)
#pragma unroll
      for (int m = 0; m < 4; ++m) {
        u16* rowp = O + (size_t)(row0 + ai * 128 + m * 16) * DFF + col0;
        f32x4 g0 = acc[ai][0][m][0], g1 = acc[ai][0][m][1], u0 = acc[ai][1][m][0], u1 = acc[ai][1][m][1];
        float v[8];
#pragma unroll
        for (int j = 0; j < 4; ++j) { v[j] = siluf_(g0[j]) * u0[j]; v[4 + j] = siluf_(g1[j]) * u1[j]; }
        u32x4 w; w.x = pg8::cvt_pk_bf16(v[0], v[1]); w.y = pg8::cvt_pk_bf16(v[2], v[3]); w.z = pg8::cvt_pk_bf16(v[4], v[5]); w.w = pg8::cvt_pk_bf16(v[6], v[7]);
        *(u32x4*)rowp = w;
      }
  }
};
struct EpiResid {
  static constexpr bool PERM = false, AFTER_DRAIN = false;
  const Params& P; int gate_off; float gs; int mode; int ln_off;
  DI void operator()(const f32x4 (&acc)[2][2][4][2], const pg8::Unit& u, int wr, int wc, int fr, int fq) const {
    const int row0 = u.pm * 256 + wr * 64 + fr, col0 = u.pn * 256 + wc * 32 + 4 * fq;
    const float* gate = P.mod + gate_off; const float* lng = P.ln_g + ln_off; const float* lnb = P.ln_b + ln_off;
#pragma unroll
    for (int ai = 0; ai < 2; ++ai)
#pragma unroll
      for (int m = 0; m < 4; ++m) {
        const int r = row0 + ai * 128 + m * 16;
        const float* xr = (mode == 0) ? (r < NCTX ? P.x_prompt + (size_t)r * 1024 : P.x_sample + (size_t)(r - NCTX) * 1024) : P.X + (size_t)r * 1024;
        const float* gr = gate + (size_t)mrow_of(r) * 9216;
        float* orow = P.X + (size_t)r * 1024;
        float mean = 0.f, rstd = 1.f;
        if (mode == 2) { const float2 ms = *(const float2*)(P.ST + 2 * (size_t)r); mean = ms.x; rstd = ms.y; }
#pragma unroll
        for (int bj = 0; bj < 2; ++bj)
#pragma unroll
          for (int n = 0; n < 2; ++n) {
            const int c = col0 + bj * 128 + n * 16;
            f32x4 x4 = *(const f32x4*)(xr + c); const f32x4 g4 = *(const f32x4*)(gr + c);
            if (mode == 2) x4 = (x4 - mean) * rstd * *(const f32x4*)(lng + c) + *(const f32x4*)(lnb + c);
            *(f32x4*)(orow + c) = x4 * ALPHA_F + (g4 * gs) * acc[ai][bj][m][n];
          }
        asm volatile("" ::: "memory");
      }
  }
};
struct EpiP {
  static constexpr bool PERM = true, AFTER_DRAIN = false;
  u16* R1; float* nak; float* nav; int l;
  DI void operator()(const f32x4 (&acc)[2][2][4][2], const pg8::Unit& u, int wr, int wc, int fr, int fq) const {
    u16* base; int ldc, colt;
    if (u.pn < 4) { base = R1; ldc = 1024; colt = u.pn * 256; }
    else if (u.pn == 4) { base = R1 + (size_t)MTOK * 1024; ldc = 256; colt = 0; }
    else if (u.pn < 10) { base = R1 + (size_t)MTOK * 1280; ldc = 1280; colt = (u.pn - 5) * 256; }
    else { base = R1 + (size_t)MTOK * 2560; ldc = 768; colt = (u.pn - 10) * 256; }
    const int row0 = u.pm * 256 + wr * 64 + fr, cw = wc * 32 + 8 * fq;
    float* fdst = (u.pn == 11) ? nak : nav;
    const bool wf = (u.pn >= 11) && (u.pm < 32);
#pragma unroll
    for (int ai = 0; ai < 2; ++ai)
#pragma unroll
      for (int m = 0; m < 4; ++m) {
        const int r = row0 + ai * 128 + m * 16;
        u16* rowp = base + (size_t)r * ldc + colt + cw;
#pragma unroll
        for (int bj = 0; bj < 2; ++bj) {
          const f32x4 v0 = acc[ai][bj][m][0], v1 = acc[ai][bj][m][1];
          u32x4 w; w.x = pg8::cvt_pk_bf16(v0[0], v0[1]); w.y = pg8::cvt_pk_bf16(v0[2], v0[3]); w.z = pg8::cvt_pk_bf16(v1[0], v1[1]); w.w = pg8::cvt_pk_bf16(v1[2], v1[3]);
          *(u32x4*)(rowp + bj * 128) = w;
          if (wf) {
            float* fp = fdst + ((size_t)(((r >> 8) * 2 + l) * 256 + (r & 255))) * 256 + bj * 128 + cw;
            *(f32x4*)fp = v0; *(f32x4*)(fp + 4) = v1;
          }
        }
      }
  }
};

template <class Epi>
DI void run_gemm(PG8_LAS unsigned char* lds, const u16* A, const u16* Bt, int M, int N, int K, const Epi& E) {
  pg8::Gemm g; g.A = A; g.Bt = Bt; g.M = M; g.N = N; g.K = K;
  pg8::StaticOrder S; S.init(M, N, (int)gridDim.x, (int)blockIdx.x);
  pg8::gemm_phase<Epi, pg8::StaticOrder, false>(lds, g, S, E, nullptr);
}

#define NCONV 5348
struct ConvJob { const float* src; u16* dst; int K, N, perm, tile; };
DI ConvJob conv_decode(const Params& P, int l, int job) {
  ConvJob j;
  if (job < 1408) { j.src = P.ffn_w_in + (size_t)(l * 2 + 0) * 1024 * 5632; j.dst = P.WA0; j.K = 1024; j.N = 5632; j.perm = 1; j.tile = job; }
  else if (job < 2816) { j.src = P.ffn_w_in + (size_t)(l * 2 + 1) * 1024 * 5632; j.dst = P.WA1; j.K = 1024; j.N = 5632; j.perm = 1; j.tile = job - 1408; }
  else if (job < 3520) { j.src = P.ffn_w_out + (size_t)(l * 2 + 0) * DFF * 1024; j.dst = P.WB0; j.K = DFF; j.N = 1024; j.perm = 0; j.tile = job - 2816; }
  else if (job < 4224) { j.src = P.ffn_w_out + (size_t)(l * 2 + 1) * DFF * 1024; j.dst = P.WB1; j.K = DFF; j.N = 1024; j.perm = 0; j.tile = job - 3520; }
  else if (job < 5056) { j.src = P.w_in + (size_t)l * 1024 * 3328; j.dst = P.WC; j.K = 1024; j.N = 3328; j.perm = 0; j.tile = job - 4224; }
  else if (job < 5312) { j.src = P.w_out + (size_t)l * 1024 * 1024; j.dst = P.WD; j.K = 1024; j.N = 1024; j.perm = 0; j.tile = job - 5056; }
  else if (job < 5328) { j.src = P.s5_glu_w + (size_t)l * 256 * 256; j.dst = P.WGLU; j.K = 256; j.N = 256; j.perm = 0; j.tile = job - 5312; }
  else if (job < 5336) { j.src = P.rw_g_up + (size_t)l * 128 * 256; j.dst = P.WGUP; j.K = 128; j.N = 256; j.perm = 0; j.tile = job - 5328; }
  else if (job < 5340) { j.src = P.rw_a_up + (size_t)l * 64 * 256; j.dst = P.WAUP; j.K = 64; j.N = 256; j.perm = 0; j.tile = job - 5336; }
  else if (job < 5344) { j.src = P.rw_w_up + (size_t)(l * 2 + 0) * 64 * 256; j.dst = P.WWUP0; j.K = 64; j.N = 256; j.perm = 0; j.tile = job - 5340; }
  else { j.src = P.rw_w_up + (size_t)(l * 2 + 1) * 64 * 256; j.dst = P.WWUP1; j.K = 64; j.N = 256; j.perm = 0; j.tile = job - 5344; }
  return j;
}
DI void conv_load(const ConvJob& j, int tidc, float (&v)[8]) {
  const int nK = j.K >> 6; const int nt = j.tile / nK, kt = j.tile - nt * nK;
  const int tx = tidc & 63, ty = tidc >> 6;
  const int np = nt * 64 + tx; int sc = np;
  if (j.perm) { const int t = np >> 8, c = np & 255; sc = (c < 128) ? (t * 128 + c) : (DFF + t * 128 + (c - 128)); }
#pragma unroll
  for (int i = 0; i < 8; ++i) v[i] = j.src[(size_t)(kt * 64 + ty + 8 * i) * j.N + sc];
}
DI void conv_store(const ConvJob& j, int tidc, const float (&v)[8], float* tl) {
  const int nK = j.K >> 6; const int nt = j.tile / nK, kt = j.tile - nt * nK;
  const int tx = tidc & 63, ty = tidc >> 6;
#pragma unroll
  for (int i = 0; i < 8; ++i) tl[(ty + 8 * i) * 65 + tx] = v[i];
  __syncthreads();
  const int r = tidc >> 3, c0 = (tidc & 7) * 8;
  u32x4 w;
  w.x = pk2(tl[(c0 + 0) * 65 + r], tl[(c0 + 1) * 65 + r]); w.y = pk2(tl[(c0 + 2) * 65 + r], tl[(c0 + 3) * 65 + r]);
  w.z = pk2(tl[(c0 + 4) * 65 + r], tl[(c0 + 5) * 65 + r]); w.w = pk2(tl[(c0 + 6) * 65 + r], tl[(c0 + 7) * 65 + r]);
  *(u32x4*)(j.dst + (size_t)(nt * 64 + r) * j.K + kt * 64 + c0) = w;
  __syncthreads();
}
DI void convert_all(const Params& P, int l, float* tl) {
  const int tidc = ltid();
  int job = blockIdx.x;
  if (job >= NCONV) return;
  ConvJob cur = conv_decode(P, l, job);
  float va[8], vb[8];
  conv_load(cur, tidc, va);
  for (;;) {
    const int j1 = job + gridDim.x;
    ConvJob n1 = cur; if (j1 < NCONV) { n1 = conv_decode(P, l, j1); conv_load(n1, tidc, vb); }
    conv_store(cur, tidc, va, tl);
    if (j1 >= NCONV) break;
    const int j2 = j1 + gridDim.x;
    ConvJob n2 = n1; if (j2 < NCONV) { n2 = conv_decode(P, l, j2); conv_load(n2, tidc, va); }
    conv_store(n1, tidc, vb, tl);
    if (j2 >= NCONV) break;
    cur = n2; job = j2;
  }
}
DI void phase_p0(const Params& P, unsigned char* lds) {
  float* tl = (float*)lds;
  float* sc = (float*)(lds + 16640);
  float* red = (float*)(lds + 16640 + 36864);
  const int tid = ltid();
  if (blockIdx.x == 0 && tid < 4) P.qctr[tid] = 0u;
  for (int i = tid; i < 9216; i += NTHR) { const int r = i >> 10, k = i & 1023; const float v = (r == 0) ? P.c_ctx[k] : P.c[(r - 1) * 1024 + k]; sc[i] = siluf_(v); }
  __syncthreads();
  convert_all(P, 0, tl);
  for (int jm = (blockIdx.x + 100) % gridDim.x; jm < 288; jm += gridDim.x) {
    const int l = jm / 144, col0 = (jm % 144) * 64;
    const int col = tid & 63, kg = tid >> 6;
    float acc[9];
#pragma unroll
    for (int r = 0; r < 9; ++r) acc[r] = 0.f;
    const float* wp = P.w_mod + (size_t)l * 1024 * 9216 + col0 + col;
    for (int k0 = kg * 128; k0 < kg * 128 + 128; k0 += 16) {
      float w[16];
#pragma unroll
      for (int i = 0; i < 16; ++i) w[i] = wp[(size_t)(k0 + i) * 9216];
#pragma unroll
      for (int i = 0; i < 16; ++i)
#pragma unroll
        for (int r = 0; r < 9; ++r) acc[r] += sc[r * 1024 + k0 + i] * w[i];
    }
#pragma unroll
    for (int r = 0; r < 9; ++r) red[(kg * 9 + r) * 64 + col] = acc[r];
    __syncthreads();
    for (int i = tid; i < 576; i += NTHR) {
      const int r = i >> 6, cc = i & 63; float s = P.b_mod[l * 9216 + col0 + cc];
#pragma unroll
      for (int g = 0; g < 8; ++g) s += red[(g * 9 + r) * 64 + cc];
      P.mod[(size_t)(l * 9 + r) * 9216 + col0 + cc] = s;
    }
    __syncthreads();
  }
}

DI void phase_lnmod(const Params& P, const float* lng, const float* lnb, const float* modl, int shoff, int from_input, int writeX) {
  const int tidl = ltid(); const int wid = tidl >> 6, lane = tidl & 63;
  for (int m = blockIdx.x * 8 + wid; m < MTOK; m += gridDim.x * 8) {
    const float* src = from_input ? (m < NCTX ? P.x_prompt + (size_t)m * 1024 : P.x_sample + (size_t)(m - NCTX) * 1024) : P.X + (size_t)m * 1024;
    f32x4 v[4];
#pragma unroll
    for (int i = 0; i < 4; ++i) v[i] = *(const f32x4*)(src + lane * 4 + 256 * i);
    if (lng) {
      float s = 0.f;
#pragma unroll
      for (int i = 0; i < 4; ++i) s += (v[i][0] + v[i][1]) + (v[i][2] + v[i][3]);
      s = wave_sum(s); const float mean = s * (1.0f / 1024.0f);
      float q = 0.f;
#pragma unroll
      for (int i = 0; i < 4; ++i) { const f32x4 d = v[i] - mean; q += (d[0] * d[0] + d[1] * d[1]) + (d[2] * d[2] + d[3] * d[3]); }
      q = wave_sum(q); const float rstd = 1.0f / sqrtf(q * (1.0f / 1024.0f) + 1e-5f);
#pragma unroll
      for (int i = 0; i < 4; ++i) {
        const int c = lane * 4 + 256 * i;
        const f32x4 g = *(const f32x4*)(lng + c), b = *(const f32x4*)(lnb + c);
        v[i] = (v[i] - mean) * rstd * g + b;
        if (writeX) *(f32x4*)(P.X + (size_t)m * 1024 + c) = v[i];
      }
      if (!writeX && lane == 0) *(float2*)(P.ST + 2 * (size_t)m) = make_float2(mean, rstd);
    }
    if (modl) {
      const float* mr = modl + (size_t)mrow_of(m) * 9216 + shoff * 1024;
#pragma unroll
      for (int i = 0; i < 4; ++i) {
        const int c = lane * 4 + 256 * i;
        const f32x4 sh = *(const f32x4*)(mr + c), scl = *(const f32x4*)(mr + 1024 + c);
        const f32x4 h = v[i] * (scl + 1.0f) + sh;
        u32x2 w; w.x = pk2(h[0], h[1]); w.y = pk2(h[2], h[3]);
        *(u32x2*)(P.H + (size_t)m * 1024 + c) = w;
      }
    }
  }
}

DI void phase_prep(const Params& P, int l, unsigned char* lds) {
  u16* Atw = (u16*)lds;
  u16* Aad = Atw + 32 * 72;
  const int tid = ltid(); const int wid = tid >> 6, lane = tid & 63, fr = lane & 15, fq = lane >> 4;
  const float* mu_p = P.rw_mu + (size_t)(l * 2 + 0) * 1024, *mu_n = P.rw_mu + (size_t)(l * 2 + 1) * 1024;
  bf16x8 bw[3][2][2];
#pragma unroll
  for (int nt = 0; nt < 2; ++nt)
#pragma unroll
    for (int ks = 0; ks < 2; ++ks) {
      const size_t o = (size_t)(wid * 32 + nt * 16 + fr) * 64 + ks * 32 + fq * 8;
      bw[0][nt][ks] = *(const bf16x8*)(P.WAUP + o); bw[1][nt][ks] = *(const bf16x8*)(P.WWUP0 + o); bw[2][nt][ks] = *(const bf16x8*)(P.WWUP1 + o);
    }
  float bias[3][2];
#pragma unroll
  for (int nt = 0; nt < 2; ++nt) { const int n = wid * 32 + nt * 16 + fr; bias[0][nt] = P.rw_a0[l * 256 + n]; bias[1][nt] = P.rw_w0[(l * 2 + 0) * 256 + n]; bias[2][nt] = P.rw_w0[(l * 2 + 1) * 256 + n]; }
  for (int g = blockIdx.x * NTHR + tid; g < 65536; g += gridDim.x * NTHR) {
    const size_t so = (size_t)(((g >> 13) * 2 + l)) * 65536 + (size_t)(g & 8191) * 8;
    const f32x4 k0 = *(const f32x4*)(P.cache_k + so), k1 = *(const f32x4*)(P.cache_k + so + 4), v0 = *(const f32x4*)(P.cache_v + so), v1 = *(const f32x4*)(P.cache_v + so + 4);
    u32x4 wk, wv; wk.x = pk2(k0[0], k0[1]); wk.y = pk2(k0[2], k0[3]); wk.z = pk2(k1[0], k1[1]); wk.w = pk2(k1[2], k1[3]);
    wv.x = pk2(v0[0], v0[1]); wv.y = pk2(v0[2], v0[3]); wv.z = pk2(v1[0], v1[1]); wv.w = pk2(v1[2], v1[3]);
    *(u32x4*)(P.KC + (size_t)g * 8) = wk; *(u32x4*)(P.VC + (size_t)g * 8) = wv;
  }
  for (int job = blockIdx.x; job < MTOK / 32; job += gridDim.x) {
    const int m0 = job * 32;
    {
      const int t = tid >> 4, cg = tid & 15; const int m = m0 + t;
      int start, len; const int s = m < NCTX ? (m >> 8) : 32 + ((m - NCTX) >> 12); seq_info(s, start, len);
      const int tt = m - start; const int col = 768 + cg * 8;
      const u16* p0 = P.R1 + (size_t)m * 1024 + col;
      u32x4 c = *(const u32x4*)p0, pv = {0, 0, 0, 0}, nx = {0, 0, 0, 0};
      if (tt > 0) pv = *(const u32x4*)(p0 - 1024);
      if (tt < len - 1) nx = *(const u32x4*)(p0 + 1024);
      float sh[8];
#pragma unroll
      for (int i = 0; i < 8; ++i) {
        const unsigned cw = c[i >> 1], pw = pv[i >> 1], nw = nx[i >> 1];
        const float x = (i & 1) ? bfhi(cw) : bflo(cw), xp = (i & 1) ? bfhi(pw) : bflo(pw), xn = (i & 1) ? bfhi(nw) : bflo(nw);
        const float v = x + mu_p[col + i] * (xp - x) + mu_n[col + i] * (xn - x);
        sh[i] = (cg < 8) ? tanhf(v) : v;
      }
      u32x4 w; w.x = pk2(sh[0], sh[1]); w.y = pk2(sh[2], sh[3]); w.z = pk2(sh[4], sh[5]); w.w = pk2(sh[6], sh[7]);
      *(u32x4*)(((cg < 8) ? Atw : Aad) + t * 72 + (cg & 7) * 8) = w;
    }
    __syncthreads();
#pragma unroll
    for (int mt = 0; mt < 2; ++mt) {
      bf16x8 atw[2], aad[2];
#pragma unroll
      for (int ks = 0; ks < 2; ++ks) { atw[ks] = *(const bf16x8*)(Atw + (mt * 16 + fr) * 72 + ks * 32 + fq * 8); aad[ks] = *(const bf16x8*)(Aad + (mt * 16 + fr) * 72 + ks * 32 + fq * 8); }
#pragma unroll
      for (int nt = 0; nt < 2; ++nt) {
        f32x4 ca = {0.f, 0.f, 0.f, 0.f}, c0 = ca, c1 = ca;
#pragma unroll
        for (int ks = 0; ks < 2; ++ks) {
          ca = __builtin_amdgcn_mfma_f32_16x16x32_bf16(aad[ks], bw[0][nt][ks], ca, 0, 0, 0);
          c0 = __builtin_amdgcn_mfma_f32_16x16x32_bf16(atw[ks], bw[1][nt][ks], c0, 0, 0, 0);
          c1 = __builtin_amdgcn_mfma_f32_16x16x32_bf16(atw[ks], bw[2][nt][ks], c1, 0, 0, 0);
        }
        const int n = wid * 32 + nt * 16 + fr;
#pragma unroll
        for (int j = 0; j < 4; ++j) {
          const size_t o = (size_t)(m0 + mt * 16 + fq * 4 + j) * 256 + n;
          P.PA[o] = f2bf(sigmoidf_(bias[0][nt] + ca[j]));
          P.PE0[o] = f2bf(0.60653066f * sigmoidf_(bias[1][nt] + c0[j]));
          P.PE1[o] = f2bf(0.60653066f * sigmoidf_(bias[2][nt] + c1[j]));
        }
      }
    }
    __syncthreads();
  }
}

DI void rwkv_unit(const Params& P, int l, int s, int h, int d, int half, unsigned char* lds) {
  int tid = threadIdx.x; asm volatile("" : "+v"(tid)); const int wid = tid >> 6, lane = tid & 63;
  const int rowl = (wid & 3) * 8 + (lane >> 3), row = half * 32 + rowl, kq = lane & 7;
  int start, len; seq_info(s, start, len);
  float* buf = (float*)lds;
  float* yst = buf + 2 * 6 * 1024;
  f32x2 S2[4];
  if (s >= 32) {
    const float* sp = P.st_rwkv + ((((size_t)(s - 32) * 2 + l) * 2 + d) * 4 + h) * 4096 + row * 64 + kq * 8;
    const f32x4 a = *(const f32x4*)sp, bq = *(const f32x4*)(sp + 4);
    S2[0] = lo2(a); S2[1] = hi2(a); S2[2] = lo2(bq); S2[3] = hi2(bq);
  } else {
#pragma unroll
    for (int i = 0; i < 4; ++i) S2[i] = (f32x2){0.f, 0.f};
  }
  const int ptok = tid >> 5, pc = (tid & 31) * 2;
  float mup[3][2], mun[3][2];
#pragma unroll
  for (int k = 0; k < 3; ++k)
#pragma unroll
    for (int e = 0; e < 2; ++e) { mup[k][e] = P.rw_mu[(size_t)(l * 2 + 0) * 1024 + k * 256 + h * 64 + pc + e]; mun[k][e] = P.rw_mu[(size_t)(l * 2 + 1) * 1024 + k * 256 + h * 64 + pc + e]; }
  const float kk0 = P.rw_k_k[l * 256 + h * 64 + pc], kk1 = P.rw_k_k[l * 256 + h * 64 + pc + 1];
  const float ka0 = P.rw_k_a[l * 256 + h * 64 + pc], ka1 = P.rw_k_a[l * 256 + h * 64 + pc + 1];
  const u16* pe = d ? P.PE1 : P.PE0;
  u16* outp = d ? P.YB : P.H; const int ldo = d ? 256 : 1024;
  const int nch = len >> 4;
  unsigned rawA[11], rawB[11], rawC[11], rawD[11];
#define RW_ISSUE(ci, raw) do { const int t0_ = d ? (len - 16 - (ci) * 16) : (ci) * 16; const int t_ = t0_ + ptok; const size_t m_ = (size_t)(start + t_); \
    _Pragma("unroll") for (int k_ = 0; k_ < 3; ++k_) { const u16* p_ = P.R1 + m_ * 1024 + k_ * 256 + h * 64 + pc; \
      raw[k_ * 3 + 0] = (t_ > 0) ? *(const unsigned*)(p_ - 1024) : 0u; raw[k_ * 3 + 1] = *(const unsigned*)p_; raw[k_ * 3 + 2] = (t_ < len - 1) ? *(const unsigned*)(p_ + 1024) : 0u; } \
    raw[9] = *(const unsigned*)(P.PA + m_ * 256 + h * 64 + pc); raw[10] = *(const unsigned*)(pe + m_ * 256 + h * 64 + pc); } while (0)
#define RW_FLUSH(ci, b) do { const int t0_ = d ? (len - 16 - (ci) * 16) : (ci) * 16; \
    outp[(size_t)(start + t0_ + ptok) * ldo + h * 64 + half * 32 + (tid & 31)] = f2bf(yst[(b) * 1024 + ptok * 64 + (tid & 31)]); } while (0)
  RW_ISSUE(0, rawA); RW_ISSUE(1, rawB); RW_ISSUE(2, rawC); RW_ISSUE(3, rawD);
  auto body = [&](unsigned (&raw)[11], const int ci, const int b) __attribute__((always_inline)) {
    {
      float sh[3][2];
#pragma unroll
      for (int k = 0; k < 3; ++k) {
        const unsigned pw = raw[k * 3], cw = raw[k * 3 + 1], nw = raw[k * 3 + 2];
        const float c0 = bflo(cw), c1 = bfhi(cw);
        sh[k][0] = c0 + mup[k][0] * (bflo(pw) - c0) + mun[k][0] * (bflo(nw) - c0);
        sh[k][1] = c1 + mup[k][1] * (bfhi(pw) - c1) + mun[k][1] * (bfhi(nw) - c1);
      }
      const float a0 = bflo(raw[9]), a1 = bfhi(raw[9]), e0 = bflo(raw[10]), e1 = bfhi(raw[10]);
      const float q0 = sh[1][0] * kk0, q1 = sh[1][1] * kk1;
      float ss = q0 * q0 + q1 * q1;
      ss = hsum32(ss);
      const float inv = 1.0f / fmaxf(sqrtf(ss), 1e-12f);
      const float n0 = q0 * inv, n1 = q1 * inv;
      float* B = buf + b * 6144 + ptok * 64 + pc;
      *(float2*)(B + 0 * 1024) = make_float2(sh[0][0], sh[0][1]);
      *(float2*)(B + 1 * 1024) = make_float2(__expf(-e0), __expf(-e1));
      *(float2*)(B + 2 * 1024) = make_float2(sh[1][0] * (1.f + (a0 - 1.f) * ka0), sh[1][1] * (1.f + (a1 - 1.f) * ka1));
      *(float2*)(B + 3 * 1024) = make_float2(sh[2][0], sh[2][1]);
      *(float2*)(B + 4 * 1024) = make_float2(n0, n1);
      *(float2*)(B + 5 * 1024) = make_float2(n0 * a0, n1 * a1);
    }
    asm volatile("s_waitcnt lgkmcnt(0)" ::: "memory"); __builtin_amdgcn_s_barrier(); asm volatile("" ::: "memory");
    if ((ci) > 0) RW_FLUSH((ci) - 1, (b) ^ 1);
    if ((ci) + 4 < nch) RW_ISSUE((ci) + 4, raw);
    if (wid < 4) {
      struct Ops { f32x4 r0, r1, w0, w1, k0, k1, c0, c1, b0, b1; float vv; };
#define RW_LD(o, st_) do { const int tt_ = d ? 15 - (st_) : (st_); const float* B_ = buf + b * 6144 + tt_ * 64 + kq * 8; \
        o.r0 = *(const f32x4*)(B_); o.r1 = *(const f32x4*)(B_ + 4); o.w0 = *(const f32x4*)(B_ + 1024); o.w1 = *(const f32x4*)(B_ + 1028); \
        o.k0 = *(const f32x4*)(B_ + 2048); o.k1 = *(const f32x4*)(B_ + 2052); o.c0 = *(const f32x4*)(B_ + 4096); o.c1 = *(const f32x4*)(B_ + 4100); \
        o.b0 = *(const f32x4*)(B_ + 5120); o.b1 = *(const f32x4*)(B_ + 5124); o.vv = buf[b * 6144 + 3072 + tt_ * 64 + row]; } while (0)
      Ops ring[2];
      RW_LD(ring[0], 0);
      __builtin_amdgcn_sched_group_barrier(0x100, 11, 0);
      float ykeep = 0.f;
      f32x4 pr0 = {0.f, 0.f, 0.f, 0.f}, pr1 = pr0;
#pragma unroll
      for (int st = 0; st < 16; ++st) {
        if (st < 15) RW_LD(ring[(st + 1) % 2], st + 1);
        const Ops& cur = ring[st % 2];
        const f32x2 a0 = S2[0] * lo2(cur.c0) + S2[1] * hi2(cur.c0), a1 = S2[2] * lo2(cur.c1) + S2[3] * hi2(cur.c1);
        const f32x2 a2 = a0 + a1;
        float ysum = 0.f;
        if (st > 0) { const f32x2 y0 = S2[0] * lo2(pr0) + S2[1] * hi2(pr0), y1 = S2[2] * lo2(pr1) + S2[3] * hi2(pr1); const f32x2 y2 = y0 + y1; ysum = y2[0] + y2[1]; }
        const float sa = -red8(a2[0] + a2[1]);
        if (st > 0) { const float yv = red8(ysum); ykeep = (kq == ((st - 1) & 7)) ? yv : ykeep;
          if (((st - 1) & 7) == 7) { const int tk = ((st - 1) & 8) + kq; yst[b * 1024 + (d ? 15 - tk : tk) * 64 + rowl] = ykeep; } }
        const f32x2 sa2 = {sa, sa}, vv2 = {cur.vv, cur.vv};
        S2[0] = S2[0] * lo2(cur.w0) + (sa2 * lo2(cur.b0) + vv2 * lo2(cur.k0));
        S2[1] = S2[1] * hi2(cur.w0) + (sa2 * hi2(cur.b0) + vv2 * hi2(cur.k0));
        S2[2] = S2[2] * lo2(cur.w1) + (sa2 * lo2(cur.b1) + vv2 * lo2(cur.k1));
        S2[3] = S2[3] * hi2(cur.w1) + (sa2 * hi2(cur.b1) + vv2 * hi2(cur.k1));
        pr0 = cur.r0; pr1 = cur.r1;
        __builtin_amdgcn_sched_group_barrier(0x100, 11, 0);
        __builtin_amdgcn_sched_group_barrier(0x002, 34, 0);
      }
      { const f32x2 y0 = S2[0] * lo2(pr0) + S2[1] * hi2(pr0), y1 = S2[2] * lo2(pr1) + S2[3] * hi2(pr1); const f32x2 y2 = y0 + y1;
        const float yv = red8(y2[0] + y2[1]); ykeep = (kq == 7) ? yv : ykeep; const int tk = 8 + kq; yst[b * 1024 + (d ? 15 - tk : tk) * 64 + rowl] = ykeep; }
#undef RW_LD
    }
  };
  for (int ci2 = 0; ci2 < nch; ci2 += 4) { body(rawA, ci2, 0); body(rawB, ci2 + 1, 1); body(rawC, ci2 + 2, 0); body(rawD, ci2 + 3, 1); }
  __syncthreads();
  RW_FLUSH(nch - 1, (nch - 1) & 1);
  if (s < 32) {
    float* op = P.o_rwkv + ((((size_t)s * 2 + l) * 2 + d) * 4 + h) * 4096 + row * 64 + kq * 8;
    if (wid < 4) { *(f32x4*)op = (f32x4){S2[0][0], S2[0][1], S2[1][0], S2[1][1]}; *(f32x4*)(op + 4) = (f32x4){S2[2][0], S2[2][1], S2[3][0], S2[3][1]}; }
  }
  __syncthreads();
#undef RW_ISSUE
#undef RW_FLUSH
}

DI void hgrn_unit(const Params& P, int l, int s, int h, int d, int half, unsigned char* lds) {
  int tid = threadIdx.x; asm volatile("" : "+v"(tid)); const int wid = tid >> 6, lane = tid & 63;
  const int coll = wid * 8 + (lane >> 3), col = coll, kq = lane & 7;
  int start, len; seq_info(s, start, len);
  float* buf = (float*)lds;
  float* yst = buf + 2 * 4 * 1024;
  f32x2 S2[4];
  if (s >= 32) {
    const float* sp = P.st_hgrn + ((((size_t)(s - 32) * 2 + l) * 2 + d) * 4 + h) * 4096;
#pragma unroll
    for (int i = 0; i < 4; ++i) S2[i] = (f32x2){sp[(kq * 8 + 2 * i) * 64 + col], sp[(kq * 8 + 2 * i + 1) * 64 + col]};
  } else {
#pragma unroll
    for (int i = 0; i < 4; ++i) S2[i] = (f32x2){0.f, 0.f};
  }
  const int ptok = tid >> 5, pc = (tid & 31) * 2;
  float lb0 = 0.f, lb1 = 0.f;
  if (l == 1) {
    const float h00 = P.hg_lb[h * 64 + pc], h01 = P.hg_lb[h * 64 + pc + 1], h10 = P.hg_lb[256 + h * 64 + pc], h11 = P.hg_lb[256 + h * 64 + pc + 1];
    lb0 = 1.0f / (1.0f + expf(h00 - h10)); lb1 = 1.0f / (1.0f + expf(h01 - h11));
  }
  const u16* pC = P.R1 + (size_t)MTOK * 1280;
  u16* outp = d ? (P.YB + (size_t)MTOK * 512) : P.H; const int ldo = d ? 256 : 1024; const int coff = d ? 0 : 512;
  const int nch = len >> 4;
  unsigned rawA[3], rawB[3], rawC[3], rawD[3];
#define HG_ISSUE(ci, raw) do { const int t0_ = d ? (len - 16 - (ci) * 16) : (ci) * 16; const u16* p_ = pC + (size_t)(start + t0_ + ptok) * 1280 + h * 64 + pc; \
    raw[0] = *(const unsigned*)p_; raw[1] = *(const unsigned*)(p_ + 256 * (1 + d)); raw[2] = *(const unsigned*)(p_ + 768); } while (0)
#define HG_FLUSH(ci, b) do { const int t0_ = d ? (len - 16 - (ci) * 16) : (ci) * 16; \
    const float* y_ = yst + (b) * 1024 + ptok * 64 + (tid & 31) * 2; *(unsigned*)(outp + (size_t)(start + t0_ + ptok) * ldo + coff + h * 64 + (tid & 31) * 2) = pk2(y_[0], y_[1]); } while (0)
  HG_ISSUE(0, rawA); HG_ISSUE(1, rawB); HG_ISSUE(2, rawC); HG_ISSUE(3, rawD);
  auto body = [&](unsigned (&raw)[3], const int ci, const int b) __attribute__((always_inline)) {
    {
      const float q0 = bflo(raw[0]), q1 = bfhi(raw[0]), z0 = bflo(raw[1]), z1 = bfhi(raw[1]);
      const float s0 = sigmoidf_(z0), s1 = sigmoidf_(z1);
      const float f0 = fmaxf(lb0 + (1.f - lb0) * s0, 1e-30f), f1 = fmaxf(lb1 + (1.f - lb1) * s1, 1e-30f);
      const float k0 = (1.f - lb0) / (1.f + __expf(z0)), k1 = (1.f - lb1) / (1.f + __expf(z1));
      float* B = buf + b * 4096 + ptok * 64 + pc;
      *(float2*)(B) = make_float2(f0, f1);
      *(float2*)(B + 1024) = make_float2(k0, k1);
      *(float2*)(B + 2048) = make_float2(siluf_(q0), siluf_(q1));
      *(float2*)(B + 3072) = make_float2(bflo(raw[2]), bfhi(raw[2]));
    }
    asm volatile("s_waitcnt lgkmcnt(0)" ::: "memory"); __builtin_amdgcn_s_barrier(); asm volatile("" ::: "memory");
    if (ci > 0) HG_FLUSH(ci - 1, b ^ 1);
    if (ci + 4 < nch) HG_ISSUE(ci + 4, raw);
    {
      struct Ops { f32x4 f0, f1, k0, k1, q0, q1; float vv; };
#define HG_LD(o, st_) do { const int tt_ = d ? 15 - (st_) : (st_); const float* B_ = buf + b * 4096 + tt_ * 64 + kq * 8; \
        o.f0 = *(const f32x4*)(B_); o.f1 = *(const f32x4*)(B_ + 4); o.k0 = *(const f32x4*)(B_ + 1024); o.k1 = *(const f32x4*)(B_ + 1028); \
        o.q0 = *(const f32x4*)(B_ + 2048); o.q1 = *(const f32x4*)(B_ + 2052); o.vv = buf[b * 4096 + 3072 + tt_ * 64 + col]; } while (0)
      Ops ring[3];
      HG_LD(ring[0], 0); HG_LD(ring[1], 1);
      float ykeep = 0.f;
#pragma unroll
      for (int st = 0; st < 16; ++st) {
        if (st < 14) HG_LD(ring[(st + 2) % 3], st + 2);
        __builtin_amdgcn_sched_barrier(0);
        const Ops& cur = ring[st % 3];
        const f32x2 vv2 = {cur.vv, cur.vv};
        S2[0] = lo2(cur.f0) * S2[0] + lo2(cur.k0) * vv2; S2[1] = hi2(cur.f0) * S2[1] + hi2(cur.k0) * vv2;
        S2[2] = lo2(cur.f1) * S2[2] + lo2(cur.k1) * vv2; S2[3] = hi2(cur.f1) * S2[3] + hi2(cur.k1) * vv2;
        f32x2 oa = S2[0] * lo2(cur.q0); oa += S2[1] * hi2(cur.q0); oa += S2[2] * lo2(cur.q1); oa += S2[3] * hi2(cur.q1);
        const float yv = red8(oa[0] + oa[1]);
        ykeep = (kq == (st & 7)) ? yv : ykeep;
        if ((st & 7) == 7) { const int tk = (st & 8) + kq; yst[b * 1024 + (d ? 15 - tk : tk) * 64 + coll] = ykeep; }
      }
#undef HG_LD
    }
  };
  for (int ci2 = 0; ci2 < nch; ci2 += 4) { body(rawA, ci2, 0); body(rawB, ci2 + 1, 1); body(rawC, ci2 + 2, 0); body(rawD, ci2 + 3, 1); }
  __syncthreads();
  HG_FLUSH(nch - 1, (nch - 1) & 1);
  if (s < 32) {
    float* op = P.o_hgrn + ((((size_t)s * 2 + l) * 2 + d) * 4 + h) * 4096;
#pragma unroll
    for (int i = 0; i < 4; ++i) { op[(kq * 8 + 2 * i) * 64 + col] = S2[i][0]; op[(kq * 8 + 2 * i + 1) * 64 + col] = S2[i][1]; }
  }
  __syncthreads();
#undef HG_ISSUE
#undef HG_FLUSH
}

DI void s5_block(const Params& P, int l, int s, int d, int goct, unsigned char* lds) {
  int tid = threadIdx.x; asm volatile("" : "+v"(tid)); const int wid = tid >> 6, lane = tid & 63, fr = lane & 15, fq = lane >> 4;
  const int g = goct * 8 + wid;
  int start, len; seq_info(s, start, len);
  float* bu = (float*)(lds + wid * 12800);
  u16* sb = (u16*)(lds + wid * 12800 + 8448);
  float abr, abi, zr, zi;
  {
    const float dt = expf(P.s5_log_dt[(l * 2 + d) * 16 + g]);
    const float lre = P.s5_a_re[(size_t)((l * 2 + d) * 16 + g) * 64 + lane], lim = P.s5_a_im[(size_t)((l * 2 + d) * 16 + g) * 64 + lane];
    const float x = lre * dt, th = lim * dt; const float mag = expf(x); float sn, cs; sincosf(th, &sn, &cs);
    abr = mag * cs; abi = mag * sn;
    const float shalf = sinf(0.5f * th); const float abm1 = expm1f(x) * cs - 2.0f * shalf * shalf;
    const float den = lre * lre + lim * lim;
    zr = (abm1 * lre + abi * lim) / den; zi = (abi * lre - abm1 * lim) / den;
  }
  bf16x8 bbf[8], ccf[4];
#pragma unroll
  for (int nt = 0; nt < 8; ++nt) {
    const int nsrc = nt * 8 + (fr >> 1), ri = fr & 1;
    const float z_r = __shfl(zr, nsrc), z_i = __shfl(zi, nsrc);
    const float* br = P.s5_b_re + ((size_t)(l * 16 + g) * 64 + nsrc) * 16; const float* bi = P.s5_b_im + ((size_t)(l * 16 + g) * 64 + nsrc) * 16;
#pragma unroll
    for (int j = 0; j < 8; ++j) {
      float v = 0.f;
      if (fq < 2) { const float b_r = br[fq * 8 + j], b_i = bi[fq * 8 + j]; v = ri ? (z_r * b_i + z_i * b_r) : (z_r * b_r - z_i * b_i); }
      bbf[nt][j] = (short)f2bf(v);
    }
  }
#pragma unroll
  for (int ks = 0; ks < 4; ++ks)
#pragma unroll
    for (int j = 0; j < 8; ++j) {
      const int n = ks * 16 + fq * 4 + (j >> 1);
      const size_t ix = ((size_t)(l * 16 + g) * 16 + fr) * 64 + n;
      ccf[ks][j] = (short)f2bf((j & 1) ? -P.s5_c_im[ix] : P.s5_c_re[ix]);
    }
  float sre = 0.f, sim = 0.f;
  if (s >= 32) { const float* sp = P.st_s5 + (((((size_t)(s - 32) * 2 + l) * 2 + d) * 16 + g) * 64 + lane) * 2; sre = sp[0]; sim = sp[1]; }
  const u16* pB = P.R1 + (size_t)MTOK * 1024;
  u16* outp = d ? (P.YB + (size_t)MTOK * 256) : P.H; const int ldo = d ? 256 : 1024; const int coff = d ? 0 : 256;
  const int nch = len >> 4;
  const u32x4 zero4 = {0u, 0u, 0u, 0u};
#define S5_LOADU(ci) ((fq < 2) ? *(const u32x4*)(pB + (size_t)(start + (d ? (len - 16 - (ci) * 16) : (ci) * 16) + fr) * 256 + g * 16 + fq * 8) : zero4)
  u32x4 u0 = S5_LOADU(0), u1 = zero4, u2 = zero4;
  if (nch > 1) u1 = S5_LOADU(1);
  if (nch > 2) u2 = S5_LOADU(2);
  for (int ci = 0; ci < nch; ++ci) {
    const u32x4 uc = u0; u0 = u1; u1 = u2; if (ci + 3 < nch) u2 = S5_LOADU(ci + 3);
    const bf16x8 ua = __builtin_bit_cast(bf16x8, uc);
#pragma unroll
    for (int nt = 0; nt < 8; ++nt) {
      f32x4 acc = {0.f, 0.f, 0.f, 0.f};
      acc = __builtin_amdgcn_mfma_f32_16x16x32_bf16(ua, bbf[nt], acc, 0, 0, 0);
#pragma unroll
      for (int j = 0; j < 4; ++j) bu[(fq * 4 + j) * 132 + nt * 16 + fr] = acc[j];
    }
    asm volatile("s_waitcnt lgkmcnt(0)" ::: "memory");
    float2 bq[16];
#pragma unroll
    for (int st = 0; st < 16; ++st) bq[st] = *(const float2*)(bu + (d ? 15 - st : st) * 132 + 2 * lane);
#pragma unroll
    for (int st = 0; st < 16; ++st) {
      const int tt = d ? 15 - st : st;
      const float2 b2 = bq[st];
      const float nr = abr * sre - abi * sim + b2.x, ni = abr * sim + abi * sre + b2.y;
      sre = nr; sim = ni;
      *(unsigned*)(sb + tt * 136 + 2 * lane) = pk2(sre, sim);
    }
    asm volatile("s_waitcnt lgkmcnt(0)" ::: "memory");
    f32x4 acc = {0.f, 0.f, 0.f, 0.f};
#pragma unroll
    for (int ks = 0; ks < 4; ++ks) {
      const bf16x8 a = *(const bf16x8*)(sb + fr * 136 + ks * 32 + fq * 8);
      acc = __builtin_amdgcn_mfma_f32_16x16x32_bf16(a, ccf[ks], acc, 0, 0, 0);
    }
    const int t0 = d ? (len - 16 - ci * 16) : ci * 16;
#pragma unroll
    for (int j = 0; j < 4; ++j) outp[(size_t)(start + t0 + fq * 4 + j) * ldo + coff + g * 16 + fr] = f2bf(acc[j]);
    asm volatile("s_waitcnt lgkmcnt(0)" ::: "memory");
  }
  __syncthreads();
  if (s < 32) { float* op = P.o_s5 + (((((size_t)s * 2 + l) * 2 + d) * 16 + g) * 64 + lane) * 2; op[0] = sre; op[1] = sim; }
#undef S5_LOADU
}

DI void attn_job(const Params& P, int l, int type, int b, int rq, int hp, unsigned char* lds) {
  int tid = threadIdx.x; asm volatile("" : "+v"(tid)); const int wid = tid >> 6, lane = tid & 63, fr = lane & 15, fq = lane >> 4;
  const int hh = wid >> 2, qg = wid & 3, head = hp * 2 + hh;
  const u16* pD = P.R1 + (size_t)MTOK * 2560;
  unsigned char* ldsK = lds;
  u16* ldsV = (u16*)(lds + 32768);
  float* rpbL = (float*)(lds + 32768 + 36864);
  const int mq0 = type == 0 ? (NCTX + b * 4096 + rq * 64) : (b * 256 + rq * 64);
  const int mq = mq0 + qg * 16 + fr;
  bf16x8 qf[2];
  qf[0] = *(const bf16x8*)(pD + (size_t)mq * 768 + head * 64 + fq * 8);
  qf[1] = *(const bf16x8*)(pD + (size_t)mq * 768 + head * 64 + 32 + fq * 8);
  const int nchunks = type == 0 ? 12 : 4, nloc = type == 0 ? 8 : 4;
  const int rs = type == 0 ? min(max(rq - 4, 0), 56) : 0;
  const int mk0 = type == 0 ? (NCTX + b * 4096 + rs * 64) : (b * 256);
  if (type == 0) for (int i = tid; i < 930; i += NTHR) rpbL[i] = P.na_rpb[(size_t)(l * 4 + hp * 2) * 465 + i];
  const int sh = tid >> 8, skey = (tid >> 2) & 63, sdq = tid & 3, shead = hp * 2 + sh;
  u32x4 krA[2], vrA[2], krB[2], vrB[2];
#define AT_ISSUE(ci, kr, vr) do { const u16* kp_; const u16* vp_; \
    if ((ci) < nloc) { kp_ = pD + (size_t)(mk0 + (ci) * 64 + skey) * 768 + 256 + shead * 64 + sdq * 16; vp_ = kp_ + 256; } \
    else { const size_t o_ = ((size_t)(b * 256 + ((ci) - nloc) * 64 + skey)) * 256 + shead * 64 + sdq * 16; kp_ = P.KC + o_; vp_ = P.VC + o_; } \
    kr[0] = *(const u32x4*)kp_; kr[1] = *(const u32x4*)(kp_ + 8); vr[0] = *(const u32x4*)vp_; vr[1] = *(const u32x4*)(vp_ + 8); } while (0)
  float mrun = -1e30f, lrun = 0.f;
  f32x4 oacc[4];
#pragma unroll
  for (int i = 0; i < 4; ++i) oacc[i] = (f32x4){0.f, 0.f, 0.f, 0.f};
  const int w = qg * 16 + fr; const int cs = min(max(w - 8, 0), 48);
  AT_ISSUE(0, krA, vrA); AT_ISSUE(1, krB, vrB);
  auto chunk = [&](u32x4 (&kr)[2], u32x4 (&vr)[2], const int ci, const int buf) __attribute__((always_inline)) {
    {
      const u32x4 k0 = kr[0], k1 = kr[1], v0 = vr[0], v1 = vr[1];
      unsigned char* kb = ldsK + (buf * 2 + sh) * 8192 + skey * 128; const int sw = (skey >> 1) & 7;
      *(u32x4*)(kb + (((2 * sdq) ^ sw) << 4)) = k0; *(u32x4*)(kb + (((2 * sdq + 1) ^ sw) << 4)) = k1;
      u16* vt = ldsV + (buf * 2 + sh) * (64 * 72) + (sdq * 16) * 72 + skey;
#pragma unroll
      for (int i = 0; i < 4; ++i) { vt[(2 * i) * 72] = (u16)(v0[i] & 0xffffu); vt[(2 * i + 1) * 72] = (u16)(v0[i] >> 16);
                                    vt[(8 + 2 * i) * 72] = (u16)(v1[i] & 0xffffu); vt[(8 + 2 * i + 1) * 72] = (u16)(v1[i] >> 16); }
    }
    __syncthreads();
    if (ci + 2 < nchunks) AT_ISSUE(ci + 2, kr, vr);
    const unsigned char* kb = ldsK + (buf * 2 + hh) * 8192;
    const u16* vb = ldsV + (buf * 2 + hh) * (64 * 72);
    f32x4 sacc[4];
#pragma unroll
    for (int kt = 0; kt < 4; ++kt) {
      sacc[kt] = (f32x4){0.f, 0.f, 0.f, 0.f};
#pragma unroll
      for (int ks = 0; ks < 2; ++ks) {
        const bf16x8 a = *(const bf16x8*)(kb + (kt * 16 + fr) * 128 + (((ks * 4 + fq) ^ ((fr >> 1) & 7)) << 4));
        sacc[kt] = __builtin_amdgcn_mfma_f32_16x16x32_bf16(a, qf[ks], sacc[kt], 0, 0, 0);
      }
    }
    float mx = -1e30f;
    if (type == 0 && ci < nloc) {
      const int dr = rs + ci - rq + 7;
      const float* bp = rpbL + hh * 465 + dr * 31;
#pragma unroll
      for (int kt = 0; kt < 4; ++kt)
#pragma unroll
        for (int j = 0; j < 4; ++j) {
          const int kc = kt * 16 + fq * 4 + j; const bool valid = (kc >= cs) && (kc < cs + 16);
          const int dc = min(max(kc - w + 15, 0), 30);
          const float sv = valid ? (sacc[kt][j] * 0.125f + bp[dc]) : -1e30f;
          sacc[kt][j] = sv; mx = fmaxf(mx, sv);
        }
    } else {
#pragma unroll
      for (int kt = 0; kt < 4; ++kt)
#pragma unroll
        for (int j = 0; j < 4; ++j) { const float sv = sacc[kt][j] * 0.125f; sacc[kt][j] = sv; mx = fmaxf(mx, sv); }
    }
    mx = fmaxf(mx, __shfl_xor(mx, 16)); mx = fmaxf(mx, __shfl_xor(mx, 32));
    const float mnew = fmaxf(mrun, mx); const float alpha = __expf(mrun - mnew);
    float ps = 0.f;
#pragma unroll
    for (int kt = 0; kt < 4; ++kt)
#pragma unroll
      for (int j = 0; j < 4; ++j) { const float pv = __expf(sacc[kt][j] - mnew); sacc[kt][j] = pv; ps += pv; }
    ps += __shfl_xor(ps, 16); ps += __shfl_xor(ps, 32);
    lrun = lrun * alpha + ps; mrun = mnew;
    bf16x8 pb[2];
#pragma unroll
    for (int k2 = 0; k2 < 2; ++k2) {
      u32x4 t; t.x = pk2(sacc[2 * k2][0], sacc[2 * k2][1]); t.y = pk2(sacc[2 * k2][2], sacc[2 * k2][3]);
      t.z = pk2(sacc[2 * k2 + 1][0], sacc[2 * k2 + 1][1]); t.w = pk2(sacc[2 * k2 + 1][2], sacc[2 * k2 + 1][3]);
      pb[k2] = __builtin_bit_cast(bf16x8, t);
    }
#pragma unroll
    for (int mt = 0; mt < 4; ++mt) {
      oacc[mt] = oacc[mt] * alpha;
#pragma unroll
      for (int k2 = 0; k2 < 2; ++k2) {
        const u16* vp = vb + (mt * 16 + fr) * 72 + (2 * k2) * 16 + fq * 4;
        const u32x2 lo = *(const u32x2*)vp, hi = *(const u32x2*)(vp + 16);
        const u32x4 av = {lo.x, lo.y, hi.x, hi.y};
        oacc[mt] = __builtin_amdgcn_mfma_f32_16x16x32_bf16(__builtin_bit_cast(bf16x8, av), pb[k2], oacc[mt], 0, 0, 0);
      }
    }
  };
  for (int ci2 = 0; ci2 < nchunks; ci2 += 2) { chunk(krA, vrA, ci2, 0); chunk(krB, vrB, ci2 + 1, 1); }
  const float il = 1.0f / lrun;
#pragma unroll
  for (int mt = 0; mt < 4; ++mt) {
    u32x2 o; o.x = pk2(oacc[mt][0] * il, oacc[mt][1] * il); o.y = pk2(oacc[mt][2] * il, oacc[mt][3] * il);
    *(u32x2*)(P.H + (size_t)mq * 1024 + 768 + head * 64 + mt * 16 + fq * 4) = o;
  }
  __syncthreads();
#undef AT_ISSUE
}

#define NMIXJOBS 2400
#ifndef PROBE_JOBLO
#define PROBE_JOBLO 0
#define PROBE_JOBHI 0
#endif
DI void phase_mixer(const Params& P, int l, unsigned char* lds, volatile int* sjob, unsigned long long& pacc) {
  for (;;) {
    __syncthreads();
    if (threadIdx.x == 0) *sjob = (int)atomicAdd(P.qctr + l, 1u);
    __syncthreads();
    const int job = *sjob;
    if (job >= NMIXJOBS) break;
    int kind, a0, a1, a2, a3 = 0, a4 = 0;
    if (job < 32) { const int u = job; kind = 2; a0 = 32 + (u >> 2); a1 = (u >> 1) & 1; a2 = u & 1; }
    else if (job < 160) { const int u = job - 32; kind = 0; a0 = 32 + (u >> 4); a1 = (u >> 2) & 3; a2 = (u >> 1) & 1; a4 = u & 1; }
    else if (job < 224) { const int u = job - 160; kind = 1; a0 = 32 + (u >> 3); a1 = (u >> 1) & 3; a2 = u & 1; }
    else if (job < 736) { const int u = job - 224; kind = 0; a0 = u >> 4; a1 = (u >> 2) & 3; a2 = (u >> 1) & 1; a4 = u & 1; }
    else if (job < 992) { const int u = job - 736; kind = 1; a0 = u >> 3; a1 = (u >> 1) & 3; a2 = u & 1; }
    else if (job < 1120) { const int u = job - 992; kind = 2; a0 = u >> 2; a1 = (u >> 1) & 1; a2 = u & 1; }
    else if (job < 2144) { const int u = job - 1120; kind = 3; a0 = u >> 7; a1 = (u >> 1) & 63; a2 = u & 1; a3 = 0; }
    else { const int u = job - 2144; kind = 3; a0 = u >> 3; a1 = (u >> 1) & 3; a2 = u & 1; a3 = 1; }
    const unsigned long long tj0 = (PROBE_JOBHI > 0) ? __builtin_amdgcn_s_memrealtime() : 0ull;
    if (kind == 0) rwkv_unit(P, l, a0, a1, a2, a4, lds);
    else if (kind == 1) hgrn_unit(P, l, a0, a1, a2, a4, lds);
    else if (kind == 2) s5_block(P, l, a0, a1, a2, lds);
    else attn_job(P, l, a3, a0, a1, a2, lds);
    if (PROBE_JOBHI > 0 && job >= PROBE_JOBLO && job < PROBE_JOBHI) pacc += __builtin_amdgcn_s_memrealtime() - tj0;
  }
}

DI void phase_final(const Params& P, int l, unsigned char* lds) {
  u16* sgA = (u16*)lds;
  u16* glA = sgA + 32 * 136;
  float* oaL = (float*)(glA + 32 * 264);
  const int tid = ltid(); const int wid = tid >> 6, lane = tid & 63, fr = lane & 15, fq = lane >> 4;
  const int cp = tid & 127, tg = tid >> 7, c0 = cp * 2;
  const u16* pA = P.R1; const u16* pB = P.R1 + (size_t)MTOK * 1024; const u16* pC = P.R1 + (size_t)MTOK * 1280;
  float mup[3][2], mun[3][2];
#pragma unroll
  for (int k = 0; k < 3; ++k)
#pragma unroll
    for (int e = 0; e < 2; ++e) { mup[k][e] = P.rw_mu[(size_t)(l * 2 + 0) * 1024 + k * 256 + c0 + e]; mun[k][e] = P.rw_mu[(size_t)(l * 2 + 1) * 1024 + k * 256 + c0 + e]; }
  const float2 k_a = *(const float2*)(P.rw_k_a + l * 256 + c0), r_k = *(const float2*)(P.rw_r_k + l * 256 + c0);
  const float2 lnxg = *(const float2*)(P.rw_lnx_g + l * 256 + c0), lnxb = *(const float2*)(P.rw_lnx_b + l * 256 + c0);
  const float2 s5d = *(const float2*)(P.s5_d + l * 256 + c0), hgg = *(const float2*)(P.hg_norm_g + l * 256 + c0);
  float glub[2];
#pragma unroll
  for (int nt = 0; nt < 2; ++nt) glub[nt] = P.s5_glu_b[l * 256 + wid * 32 + nt * 16 + fr];
  for (int job = blockIdx.x; job < MTOK / 32; job += gridDim.x) {
    const int m0 = job * 32;
    int start, len; { const int s = m0 < NCTX ? (m0 >> 8) : 32 + ((m0 - NCTX) >> 12); seq_info(s, start, len); }
    {
      const int t = tid >> 4, cg = tid & 15; const int m = m0 + t, tt = m - start; const int col = 896 + cg * 8;
      const u16* p0 = pA + (size_t)m * 1024 + col;
      u32x4 cc = *(const u32x4*)p0, pv = {0, 0, 0, 0}, nx = {0, 0, 0, 0};
      if (tt > 0) pv = *(const u32x4*)(p0 - 1024);
      if (tt < len - 1) nx = *(const u32x4*)(p0 + 1024);
      float sh[8];
#pragma unroll
      for (int i = 0; i < 8; ++i) {
        const unsigned cw = cc[i >> 1], pw = pv[i >> 1], nw = nx[i >> 1];
        const float x = (i & 1) ? bfhi(cw) : bflo(cw), xp = (i & 1) ? bfhi(pw) : bflo(pw), xn = (i & 1) ? bfhi(nw) : bflo(nw);
        sh[i] = sigmoidf_(x + P.rw_mu[(size_t)(l * 2 + 0) * 1024 + col + i] * (xp - x) + P.rw_mu[(size_t)(l * 2 + 1) * 1024 + col + i] * (xn - x));
      }
      u32x4 w; w.x = pk2(sh[0], sh[1]); w.y = pk2(sh[2], sh[3]); w.z = pk2(sh[4], sh[5]); w.w = pk2(sh[6], sh[7]);
      *(u32x4*)(sgA + t * 136 + cg * 8) = w;
    }
#pragma unroll 4
    for (int ti = 0; ti < 8; ++ti) {
      const int t = tg * 8 + ti; const int m = m0 + t, tt = m - start;
      const unsigned yf = *(const unsigned*)(P.H + (size_t)m * 1024 + c0), yb = *(const unsigned*)(P.YB + (size_t)m * 256 + c0);
      const float y0 = bflo(yf) + bflo(yb), y1 = bfhi(yf) + bfhi(yb);
      const float mean = hsum32(y0 + y1) * (1.0f / 64.0f); const float d0 = y0 - mean, d1 = y1 - mean;
      const float var = hsum32(d0 * d0 + d1 * d1) * (1.0f / 64.0f); const float rs = 1.0f / sqrtf(var + 64e-5f);
      float sh[3][2];
#pragma unroll
      for (int k = 0; k < 3; ++k) {
        const u16* p0 = pA + (size_t)m * 1024 + k * 256 + c0;
        const unsigned cw = *(const unsigned*)p0, pw = (tt > 0) ? *(const unsigned*)(p0 - 1024) : 0u, nw = (tt < len - 1) ? *(const unsigned*)(p0 + 1024) : 0u;
        const float x0 = bflo(cw), x1 = bfhi(cw);
        sh[k][0] = x0 + mup[k][0] * (bflo(pw) - x0) + mun[k][0] * (bflo(nw) - x0);
        sh[k][1] = x1 + mup[k][1] * (bfhi(pw) - x1) + mun[k][1] * (bfhi(nw) - x1);
      }
      const unsigned aw = *(const unsigned*)(P.PA + (size_t)m * 256 + c0);
      const float ke0 = sh[1][0] * (1.f + (bflo(aw) - 1.f) * k_a.x), ke1 = sh[1][1] * (1.f + (bfhi(aw) - 1.f) * k_a.y);
      const float bsum = hsum32(sh[0][0] * ke0 * r_k.x + sh[0][1] * ke1 * r_k.y);
      *(float2*)(oaL + t * 258 + c0) = make_float2(d0 * rs * lnxg.x + lnxb.x + bsum * sh[2][0], d1 * rs * lnxg.y + lnxb.y + bsum * sh[2][1]);
      const unsigned sf = *(const unsigned*)(P.H + (size_t)m * 1024 + 256 + c0), sb2 = *(const unsigned*)(P.YB + (size_t)(MTOK + m) * 256 + c0), uw = *(const unsigned*)(pB + (size_t)m * 256 + c0);
      const float ys0 = bflo(sf) + bflo(sb2) + s5d.x * bflo(uw), ys1 = bfhi(sf) + bfhi(sb2) + s5d.y * bfhi(uw);
      const float gl0 = 0.5f * ys0 * (1.0f + tanhf(0.7978845608f * (ys0 + 0.044715f * ys0 * ys0 * ys0)));
      const float gl1 = 0.5f * ys1 * (1.0f + tanhf(0.7978845608f * (ys1 + 0.044715f * ys1 * ys1 * ys1)));
      *(unsigned*)(glA + t * 264 + c0) = pk2(gl0, gl1);
      const unsigned of = *(const unsigned*)(P.H + (size_t)m * 1024 + 512 + c0), ob = *(const unsigned*)(P.YB + (size_t)(2 * MTOK + m) * 256 + c0), gw = *(const unsigned*)(pC + (size_t)m * 1280 + 1024 + c0);
      const float o0 = bflo(of) + bflo(ob), o1 = bfhi(of) + bfhi(ob);
      const float ms = hsum32(o0 * o0 + o1 * o1) * (1.0f / 64.0f); const float ir = 1.0f / sqrtf(ms + 1e-5f);
      *(unsigned*)(P.H + (size_t)m * 1024 + 512 + c0) = pk2(o0 * ir * hgg.x * siluf_(bflo(gw)), o1 * ir * hgg.y * siluf_(bfhi(gw)));
    }
    __syncthreads();
#pragma unroll
    for (int nt = 0; nt < 2; ++nt) {
      const int n = wid * 32 + nt * 16 + fr;
      f32x4 cg2[2], cl[2];
#pragma unroll
      for (int mt = 0; mt < 2; ++mt) { cg2[mt] = (f32x4){0.f, 0.f, 0.f, 0.f}; cl[mt] = cg2[mt]; }
#pragma unroll
      for (int ks = 0; ks < 8; ++ks) {
        const bf16x8 bgl = *(const bf16x8*)(P.WGLU + (size_t)n * 256 + ks * 32 + fq * 8);
#pragma unroll
        for (int mt = 0; mt < 2; ++mt) cl[mt] = __builtin_amdgcn_mfma_f32_16x16x32_bf16(*(const bf16x8*)(glA + (mt * 16 + fr) * 264 + ks * 32 + fq * 8), bgl, cl[mt], 0, 0, 0);
        if (ks < 4) {
          const bf16x8 bgu = *(const bf16x8*)(P.WGUP + (size_t)n * 128 + ks * 32 + fq * 8);
#pragma unroll
          for (int mt = 0; mt < 2; ++mt) cg2[mt] = __builtin_amdgcn_mfma_f32_16x16x32_bf16(*(const bf16x8*)(sgA + (mt * 16 + fr) * 136 + ks * 32 + fq * 8), bgu, cg2[mt], 0, 0, 0);
        }
      }
#pragma unroll
      for (int mt = 0; mt < 2; ++mt)
#pragma unroll
        for (int j = 0; j < 4; ++j) {
          const int t = mt * 16 + fq * 4 + j; const size_t o = (size_t)(m0 + t) * 1024 + n;
          P.H[o] = f2bf(oaL[t * 258 + n] * cg2[mt][j]);
          P.H[o + 256] = f2bf(bf2f(glA[t * 264 + n]) * sigmoidf_(cl[mt][j] + glub[nt]));
        }
    }
    __syncthreads();
  }
}

#define NPHASES 26
DI void run_phase(const Params& P, int ph, unsigned char* lds, volatile int* sjob, unsigned long long& pacc) {
  PG8_LAS unsigned char* ldsa = (PG8_LAS unsigned char*)lds;
  if (ph == 0) { phase_p0(P, lds); return; }
  if (ph == 25) { phase_lnmod(P, P.ln_g + (size_t)(1 * 3 + 2) * 1024, P.ln_b + (size_t)(1 * 3 + 2) * 1024, nullptr, 0, 0, 1); return; }
  const int l = (ph - 1) / 12, sp = (ph - 1) % 12;
  const float* modl = P.mod + (size_t)l * 9 * 9216;
  const float* lng = P.ln_g + (size_t)l * 3 * 1024; const float* lnb = P.ln_b + (size_t)l * 3 * 1024;
  switch (sp) {
    case 0:
      if (l == 0) phase_lnmod(P, nullptr, nullptr, modl, 0, 1, 0);
      else {
        convert_all(P, 1, (float*)lds);
        phase_lnmod(P, P.ln_g + (size_t)(0 * 3 + 2) * 1024, P.ln_b + (size_t)(0 * 3 + 2) * 1024, modl, 0, 0, 0);
      }
      break;
    case 1: { EpiSwiglu E; E.O = P.R1; run_gemm(ldsa, P.H, P.WA0, MTOK, 5632, 1024, E); } break;
    case 2: { EpiResid E{P, l * 9 * 9216 + 2 * 1024, 0.5f, (l == 0) ? 0 : 2, 2 * 1024}; run_gemm(ldsa, P.R1, P.WB0, MTOK, 1024, DFF, E); } break;
    case 3: phase_lnmod(P, lng, lnb, modl, 3, 0, 0); break;
    case 4: { EpiP E; E.R1 = P.R1; E.nak = P.o_nak; E.nav = P.o_nav; E.l = l; run_gemm(ldsa, P.H, P.WC, MTOK, 3328, 1024, E); } break;
    case 5: phase_prep(P, l, lds); break;
    case 6: phase_mixer(P, l, lds, sjob, pacc); break;
    case 7: phase_final(P, l, lds); break;
    case 8: { EpiResid E{P, l * 9 * 9216 + 5 * 1024, 1.0f, 2, l * 3 * 1024}; run_gemm(ldsa, P.H, P.WD, MTOK, 1024, 1024, E); } break;
    case 9: phase_lnmod(P, lng + 1024, lnb + 1024, modl, 6, 0, 0); break;
    case 10: { EpiSwiglu E; E.O = P.R1; run_gemm(ldsa, P.H, P.WA1, MTOK, 5632, 1024, E); } break;
    case 11: { EpiResid E{P, l * 9 * 9216 + 8 * 1024, 0.5f, 2, l * 3 * 1024 + 1024}; run_gemm(ldsa, P.R1, P.WB1, MTOK, 1024, DFF, E); } break;
  }
}

extern __shared__ __attribute__((aligned(16))) unsigned char dyn_lds[];

#ifndef PROBE_MASK
#define PROBE_MASK 0
#endif
__global__ __launch_bounds__(NTHR, 2) void k_mega(Params P) {
  __shared__ uint4 xb_words;
  __shared__ int sjob_s[4];
  cg::grid_group grid = cg::this_grid();
  if (threadIdx.x == 0) xb_words = make_uint4(0u, 0u, 0u, 0u);
  __syncthreads();
  XcdBarrier xb = xcd_barrier_post(P.bar, (volatile LAS unsigned*)&xb_words);
  unsigned long long tsel = 0ull;
#pragma unroll 1
  for (int ph = 0; ph < NPHASES; ++ph) {
#if PROBE_MASK
    const unsigned long long t0 = __builtin_amdgcn_s_memrealtime();
#endif
    run_phase(P, ph, dyn_lds, sjob_s, tsel);
    if (ph == 0) grid.sync();
    else if (ph + 1 < NPHASES) xcd_barrier(xb);
#if PROBE_MASK
    if ((PROBE_MASK >> ph) & 1) tsel += __builtin_amdgcn_s_memrealtime() - t0;
#endif
  }
#if PROBE_MASK || PROBE_JOBHI
  { const unsigned long long t1 = __builtin_amdgcn_s_memrealtime(); while (__builtin_amdgcn_s_memrealtime() - t1 < tsel) __builtin_amdgcn_s_sleep(8); }
#endif
}
#if !MEGA
__global__ __launch_bounds__(NTHR, 2) void k_one(Params P, int ph) {
  __shared__ int sjob_s[4];
  unsigned long long dummy = 0ull;
  run_phase(P, ph, dyn_lds, sjob_s, dummy);
}

#endif
#define LDS_BYTES 131072

extern "C" void kernel_launch(void* const* d_in, const int* in_sizes, int n_in, void* d_out, int out_size, void* d_ws, size_t ws_size, hipStream_t stream) {
  Params P{};
  const float* const* in = (const float* const*)d_in;
  P.x_prompt = in[0]; P.x_sample = in[1]; P.cache_k = in[2]; P.cache_v = in[3]; P.st_rwkv = in[4]; P.st_s5 = in[5]; P.st_hgrn = in[6]; P.c = in[7]; P.c_ctx = in[8];
  P.w_mod = in[9]; P.b_mod = in[10]; P.ln_g = in[11]; P.ln_b = in[12]; P.ffn_w_in = in[13]; P.ffn_w_out = in[14]; P.w_in = in[15]; P.w_out = in[16];
  P.rw_mu = in[17]; P.rw_w0 = in[18]; P.rw_w_up = in[19]; P.rw_a0 = in[20]; P.rw_a_up = in[21]; P.rw_g_up = in[22]; P.rw_k_k = in[23]; P.rw_k_a = in[24]; P.rw_r_k = in[25];
  P.rw_lnx_g = in[26]; P.rw_lnx_b = in[27];
  P.s5_a_re = in[28]; P.s5_a_im = in[29]; P.s5_log_dt = in[30]; P.s5_b_re = in[31]; P.s5_b_im = in[32]; P.s5_c_re = in[33]; P.s5_c_im = in[34]; P.s5_d = in[35];
  P.s5_glu_w = in[36]; P.s5_glu_b = in[37]; P.hg_lb = in[38]; P.hg_norm_g = in[39]; P.na_rpb = in[40];
  float* out = (float*)d_out;
  P.X = out; size_t o = (size_t)MTOK * 1024;
  P.o_nak = out + o; o += (size_t)32 * 2 * 256 * 256;
  P.o_nav = out + o; o += (size_t)32 * 2 * 256 * 256;
  P.o_rwkv = out + o; o += (size_t)32 * 2 * 2 * 4 * 4096;
  P.o_s5 = out + o; o += (size_t)32 * 2 * 2 * 16 * 128;
  P.o_hgrn = out + o;
  unsigned char* w = (unsigned char*)d_ws; size_t off = 0;
  auto take = [&](size_t bytes) { unsigned char* p = w + off; off += (bytes + 255) & ~(size_t)255; return p; };
  P.qctr = (unsigned*)take(256);
  P.bar = (unsigned*)take((size_t)XCD_BAR_WORDS * 4);
  P.mod = (float*)take((size_t)2 * 9 * 9216 * 4);
  P.ST = (float*)take((size_t)MTOK * 2 * 4);
  P.WA0 = (u16*)take((size_t)5632 * 1024 * 2); P.WA1 = (u16*)take((size_t)5632 * 1024 * 2);
  P.WB0 = (u16*)take((size_t)1024 * DFF * 2); P.WB1 = (u16*)take((size_t)1024 * DFF * 2);
  P.WC = (u16*)take((size_t)3328 * 1024 * 2); P.WD = (u16*)take((size_t)1024 * 1024 * 2);
  P.WGLU = (u16*)take(256 * 256 * 2); P.WGUP = (u16*)take(256 * 128 * 2); P.WAUP = (u16*)take(256 * 64 * 2); P.WWUP0 = (u16*)take(256 * 64 * 2); P.WWUP1 = (u16*)take(256 * 64 * 2);
  P.R1 = (u16*)take((size_t)MTOK * 3328 * 2);
  P.H = (u16*)take((size_t)MTOK * 1024 * 2);
  P.PA = (u16*)take((size_t)MTOK * 256 * 2); P.PE0 = (u16*)take((size_t)MTOK * 256 * 2); P.PE1 = (u16*)take((size_t)MTOK * 256 * 2);
  P.YB = (u16*)take((size_t)MTOK * 768 * 2);
  P.KC = (u16*)take((size_t)8 * 256 * 256 * 2); P.VC = (u16*)take((size_t)8 * 256 * 256 * 2);
  if (off > ws_size) fprintf(stderr, "workspace too small: need %zu have %zu\n", off, ws_size);
  static int configured = 0;
  if (!configured) {
    (void)hipFuncSetAttribute((const void*)k_mega, hipFuncAttributeMaxDynamicSharedMemorySize, LDS_BYTES);
#if !MEGA
    (void)hipFuncSetAttribute((const void*)k_one, hipFuncAttributeMaxDynamicSharedMemorySize, LDS_BYTES);
#endif
    configured = 1;
  }
#if MEGA
  (void)hipMemsetAsync(P.bar, 0, (size_t)XCD_BAR_WORDS * 4, stream);
  void* args[] = {&P};
  hipError_t e = hipLaunchCooperativeKernel((const void*)k_mega, dim3(256), dim3(NTHR), args, LDS_BYTES, stream);
  if (e != hipSuccess) fprintf(stderr, "cooperative launch failed: %s\n", hipGetErrorString(e));
#else
  for (int ph = 0; ph < NPHASES; ++ph) k_one<<<dim3(256), dim3(NTHR), LDS_BYTES, stream>>>(P, ph);
#endif
}
```

```cpp
#include <hip/hip_runtime.h>
#include <hip/hip_cooperative_groups.h>
#include <stdint.h>
#include <cstdio>
namespace cg = cooperative_groups;

#ifndef MEGA
#define MEGA 1
#endif

typedef unsigned short u16;
typedef short bf16x8 __attribute__((ext_vector_type(8)));
typedef float f32x4 __attribute__((ext_vector_type(4)));
typedef unsigned u32x4 __attribute__((ext_vector_type(4)));
typedef unsigned u32x2 __attribute__((ext_vector_type(2)));

#define NCTX 8192
#define MTOK 40960
#define DFF 2816
#define ALPHA_F 1.41421356237f
#define NTHR 512

struct Params {
  const float *x_prompt, *x_sample, *cache_k, *cache_v, *st_rwkv, *st_s5, *st_hgrn, *c, *c_ctx;
  const float *w_mod, *b_mod, *ln_g, *ln_b, *ffn_w_in, *ffn_w_out, *w_in, *w_out;
  const float *rw_mu, *rw_w0, *rw_w_up, *rw_a0, *rw_a_up, *rw_g_up, *rw_k_k, *rw_k_a, *rw_r_k, *rw_lnx_g, *rw_lnx_b;
  const float *s5_a_re, *s5_a_im, *s5_log_dt, *s5_b_re, *s5_b_im, *s5_c_re, *s5_c_im, *s5_d, *s5_glu_w, *s5_glu_b;
  const float *hg_lb, *hg_norm_g, *na_rpb;
  float *X, *o_nak, *o_nav, *o_rwkv, *o_s5, *o_hgrn;
  u16 *WA0, *WA1, *WB0, *WB1, *WC, *WD;
  u16 *WGLU, *WGUP, *WAUP, *WWUP0, *WWUP1;
  u16 *R1, *H, *PA, *PE0, *PE1, *YB;
  u16 *KC, *VC;
  float* mod;
  float* ST;
  unsigned* qctr;
  unsigned* bar;
};

#define DI __device__ __forceinline__

DI u16 f2bf(float f) { unsigned u = __float_as_uint(f); u += 0x7fffu + ((u >> 16) & 1u); return (u16)(u >> 16); }
DI float bf2f(u16 h) { return __uint_as_float(((unsigned)h) << 16); }
DI float bflo(unsigned w) { return __uint_as_float(w << 16); }
DI float bfhi(unsigned w) { return __uint_as_float(w & 0xffff0000u); }
DI unsigned pk2(float lo, float hi) { return (unsigned)f2bf(lo) | ((unsigned)f2bf(hi) << 16); }
DI float sigmoidf_(float x) { return 1.0f / (1.0f + __expf(-x)); }
DI float siluf_(float x) { return x / (1.0f + __expf(-x)); }
DI float wave_sum(float v) {
#pragma unroll
  for (int o = 32; o >= 1; o >>= 1) v += __shfl_xor(v, o);
  return v;
}
template <int CTRL> DI float dppf(float x) { return __builtin_bit_cast(float, __builtin_amdgcn_update_dpp(0, __builtin_bit_cast(int, x), CTRL, 0xF, 0xF, true)); }
DI float red8(float x) { x += dppf<0xB1>(x); x += dppf<0x4E>(x); x += dppf<0x141>(x); return x; }
typedef float f32x2 __attribute__((ext_vector_type(2)));
DI f32x2 lo2(f32x4 v) { return (f32x2){v[0], v[1]}; }
DI f32x2 hi2(f32x4 v) { return (f32x2){v[2], v[3]}; }
DI float red16(float x) { x += dppf<0xB1>(x); x += dppf<0x4E>(x); x += dppf<0x141>(x); x += dppf<0x140>(x); return x; }
DI float hsum32(float x) { x += dppf<0xB1>(x); x += dppf<0x4E>(x); x += dppf<0x141>(x); x += dppf<0x140>(x); x += __shfl_xor(x, 16); return x; }
DI int ltid() { int t = threadIdx.x; asm volatile("" : "+v"(t)); return t; }
DI int mrow_of(int m) { return m < NCTX ? 0 : 1 + ((m - NCTX) >> 12); }
DI void seq_info(int s, int& start, int& len) { if (s < 32) { start = s * 256; len = 256; } else { start = NCTX + (s - 32) * 4096; len = 4096; } }

#define XB_TMO      128
#define XB_XCNT(j)  (256  + 64 * (j))
#define XB_XSUB(j)  (1280 + 64 * (j))
#define XB_XGEN(j)  (2304 + 64 * (j))
#define XB_TOP      3328
#define XB_TOPGEN   3392
#define XCD_BAR_WORDS 3456
#define XB_SPIN_CAP (1u << 18)
#define LAS __attribute__((address_space(3)))

__device__ __forceinline__ unsigned xb_ld(unsigned* p)              { return __hip_atomic_load(p, __ATOMIC_RELAXED, __HIP_MEMORY_SCOPE_AGENT); }
__device__ __forceinline__ unsigned xb_add(unsigned* p, unsigned v) { return __hip_atomic_fetch_add(p, v, __ATOMIC_RELAXED, __HIP_MEMORY_SCOPE_AGENT); }
__device__ __forceinline__ unsigned xb_xcc_id() { return (unsigned)__builtin_amdgcn_s_getreg((3 << 11) | 20) & 0xFu; }
#define XB_SPIN(cond, bar) do { unsigned _sp = 0; while (cond) { __builtin_amdgcn_s_sleep(1); \
    if ((++_sp & 255u) == 0u) { if (xb_ld(&(bar)[XB_TMO])) break; if (_sp > XB_SPIN_CAP) { atomicAdd(&(bar)[XB_TMO], 1u); break; } } } } while (0)

struct XcdBarrier {
    unsigned* bar; unsigned x;
    volatile LAS unsigned* st;
};

__device__ __forceinline__ XcdBarrier xcd_barrier_post(unsigned* bar, volatile LAS unsigned* st) {
    XcdBarrier b; b.bar = bar; b.x = xb_xcc_id(); b.st = st;
    if (threadIdx.x == 0) (void)xb_add(&bar[XB_XCNT(b.x)], 1u);
    return b;
}
__device__ __forceinline__ void xcd_barrier_complete(unsigned* bar, unsigned x, unsigned& nloc, unsigned& nx) {
    const unsigned G = gridDim.x * gridDim.y * gridDim.z;
    unsigned sum, cnt, mine, sp = 0u;
    for (;;) {
        sum = 0u; cnt = 0u; mine = 0u;
#pragma unroll
        for (unsigned j = 0; j < 16; ++j) { const unsigned c = xb_ld(&bar[XB_XCNT(j)]); sum += c; cnt += (c > 0u) ? 1u : 0u; mine = (j == x) ? c : mine; }
        if (sum == G) break;
        __builtin_amdgcn_s_sleep(1);
        if ((++sp & 255u) == 0u) { if (xb_ld(&bar[XB_TMO])) break; if (sp > XB_SPIN_CAP) { atomicAdd(&bar[XB_TMO], 1u); break; } }
    }
    nloc = mine > 0u ? mine : 1u; nx = cnt > 0u ? cnt : 1u;
}

__device__ __forceinline__ void xcd_barrier(const XcdBarrier& b) {
    asm volatile("s_waitcnt vmcnt(0)" ::: "memory");
    __syncthreads();
    if (threadIdx.x == 0) {
        unsigned* bar = b.bar;
        __builtin_amdgcn_s_waitcnt(0);
        unsigned nloc = b.st[0], nx = b.st[1];
        if (nloc == 0u) { xcd_barrier_complete(bar, b.x, nloc, nx); b.st[0] = nloc; b.st[1] = nx; }
        const unsigned old = xb_add(&bar[XB_XSUB(b.x)], 1u);
        const unsigned gen = old / nloc;
        if (old + 1u == (gen + 1u) * nloc) {
            __builtin_amdgcn_fence(__ATOMIC_RELEASE, "agent");
            asm volatile("s_waitcnt vmcnt(0)" ::: "memory");
            const unsigned og = xb_add(&bar[XB_TOP], 1u);
            const unsigned tg = og / nx;
            if (og + 1u == (tg + 1u) * nx) xb_add(&bar[XB_TOPGEN], 1u);
            else XB_SPIN(xb_ld(&bar[XB_TOPGEN]) == tg, bar);
            __builtin_amdgcn_fence(__ATOMIC_ACQUIRE, "agent");
            xb_add(&bar[XB_XGEN(b.x)], 1u);
            asm volatile("s_waitcnt vmcnt(0)" ::: "memory");
        } else {
            XB_SPIN(xb_ld(&bar[XB_XGEN(b.x)]) == gen, bar);
            __builtin_amdgcn_fence(__ATOMIC_ACQUIRE, "agent");
            asm volatile("s_waitcnt vmcnt(0)" ::: "memory");
        }
    }
    __syncthreads();
}

namespace pg8 {
#define PG8_LAS __attribute__((address_space(3)))
typedef unsigned short bf16_t;
typedef short bf16x8 __attribute__((ext_vector_type(8)));
typedef float f32x4 __attribute__((ext_vector_type(4)));
typedef unsigned u32x4 __attribute__((ext_vector_type(4)));
constexpr int BM = 256, BK = 64, HALF = 128, HTB = HALF * BK * 2  , STAGE_BYTES = 8 * HTB, NXCD = 8, WGM = 8;

__host__ __device__ __forceinline__ int lds_byte(int r, int c) { const int st = (r >> 4) * 2 + (c >> 5), rr = r & 15, cc = c & 31, ob = rr * 64 + cc * 2; return st * 1024 + (ob ^ (((ob >> 9) & 1) << 5)); }
__host__ __device__ __forceinline__ void stage_rc(int b, int& R, int& C) { const int st = b / 1024, sb = b % 1024, swz = sb ^ (((sb >> 9) & 1) << 5); R = (st >> 1) * 16 + swz / 64; C = (st & 1) * 32 + (swz % 64) / 2; }
__host__ __device__ __forceinline__ int perm32(int rho) { const int n = rho >> 4, i = rho & 15; return 8 * (i >> 2) + 4 * n + (i & 3); }

struct Unit { int pm, pn; };
struct Gemm { const bf16_t* A; const bf16_t* Bt; int M, N, K; };

struct StaticOrder {
    int nM, nN, nwg, G, c;
    __host__ __device__ void init(int M, int N, int G_, int c_) { nM = M / BM; nN = N / BM; nwg = nM * nN; G = G_; c = c_; }
    __host__ __device__ bool next(int i, Unit& u) const {
        const long L = (long)i * G + c; if (L >= nwg) return false;
        int wgid = (int)L; { const int q = nwg / NXCD, r = nwg % NXCD, xcd = wgid % NXCD, off = wgid / NXCD; wgid = (xcd < r ? xcd * (q + 1) : r * (q + 1) + (xcd - r) * q) + off; }
        const int nig = WGM * nN, gid = wgid / nig, fm = gid * WGM, gsz = (nM - fm) < WGM ? (nM - fm) : WGM;
        u.pm = fm + ((wgid % nig) % gsz); u.pn = (wgid % nig) / gsz; return true;
    }
    __device__ __forceinline__ void a_ready(const Unit&) const {}
    __device__ __forceinline__ void done(const Unit&) const {}
};
__device__ __forceinline__ unsigned cvt_pk_bf16(float lo, float hi) { unsigned r; asm volatile("v_cvt_pk_bf16_f32 %0, %1, %2" : "=v"(r) : "v"(lo), "v"(hi)); return r; }
template <class Epi, class Sched, bool STAMP = false>
__device__ __forceinline__ void gemm_phase(PG8_LAS unsigned char* lds, const Gemm g, const Sched& S, const Epi& E, unsigned long long* stamps) {
    int tid = threadIdx.x; asm volatile("" : "+v"(tid)); const int wid = __builtin_amdgcn_readfirstlane(tid >> 6), lane = tid & 63, wr = wid >> 2, wc = wid & 3, fr = lane & 15, fq = lane >> 4;
    const int K = g.K, nt = K / BK;
    int ts_lo = 0, ts_hi = 0, nts = 0; const unsigned long long rt_entry = STAMP ? (unsigned long long)wall_clock64() : 0ull;
#define PG8_STAMP() do { if (STAMP && wid == 0 && nts < 64) { const unsigned long long _c = (unsigned long long)clock64(); \
        ts_lo = (lane == nts) ? (int)(unsigned)_c : ts_lo; ts_hi = (lane == nts) ? (int)(unsigned)(_c >> 32) : ts_hi; ++nts; } } while (0)
    PG8_STAMP();
    unsigned voffA[2], voffB[2];
#pragma unroll
    for (int i = 0; i < 2; ++i) { int R, C; stage_rc(tid * 16 + i * 8192, R, C); const int Rb = Epi::PERM ? ((R & ~31) + perm32(R & 31)) : R;
        voffA[i] = (unsigned)(R * K + C) * 2u; voffB[i] = (unsigned)(Rb * K + C) * 2u; }
    const size_t kstep = (size_t)(BK * 2);
    const size_t hstep = (size_t)HALF * K * 2;
    const size_t tstep = 2 * hstep;
    const unsigned ldsw = (unsigned)wid * 1024u;
    const int aoff = lds_byte(wr * 64 + fr, fq * 8), boff = lds_byte(wc * 32 + fr, fq * 8);
#define PG8_SA(b, h) (((b) * 2 + (h)) * HTB)
#define PG8_SB(b, h) ((4 + (b) * 2 + (h)) * HTB)
#define PG8_STAGE(bufoff, gbase, voff) do { _Pragma("unroll") for (int _i = 0; _i < 2; ++_i) \
        __builtin_amdgcn_global_load_lds((const unsigned*)((const char*)(gbase) + (voff)[_i]), (PG8_LAS unsigned*)(lds + (bufoff) + ldsw + _i * 8192), 16, 0, 0); } while (0)
#define PG8_LDA(dst, b, h) do { _Pragma("unroll") for (int m = 0; m < 4; ++m) _Pragma("unroll") for (int k = 0; k < 2; ++k) dst[m][k] = *(const PG8_LAS bf16x8*)(lds + PG8_SA(b, h) + aoff + m * 2048 + k * 1024); } while (0)
#define PG8_LDB(dst, b, h) do { _Pragma("unroll") for (int n = 0; n < 2; ++n) _Pragma("unroll") for (int k = 0; k < 2; ++k) dst[n][k] = *(const PG8_LAS bf16x8*)(lds + PG8_SB(b, h) + boff + n * 2048 + k * 1024); } while (0)
#define PG8_MMA(ai, bj, At, Bt) do { __builtin_amdgcn_s_setprio(1); _Pragma("unroll") for (int m = 0; m < 4; ++m) _Pragma("unroll") for (int n = 0; n < 2; ++n) _Pragma("unroll") for (int k = 0; k < 2; ++k) \
        acc[ai][bj][m][n] = __builtin_amdgcn_mfma_f32_16x16x32_bf16(Bt[n][k], At[m][k], acc[ai][bj][m][n], 0, 0, 0); __builtin_amdgcn_s_setprio(0); } while (0)
#define PG8_WAIT_V(n) asm volatile("s_waitcnt vmcnt(" #n ")" ::: "memory")
#define PG8_WAIT_L(n) asm volatile("s_waitcnt lgkmcnt(" #n ")" ::: "memory")
#define PG8_BAR __builtin_amdgcn_s_barrier()
#define PG8_SCHED __builtin_amdgcn_sched_barrier(0)
    Unit cur, nxt; int ui = 0;
    if (!S.next(0, cur)) return;
    f32x4 acc[2][2][4][2];
#pragma unroll
    for (int a = 0; a < 2; ++a)
#pragma unroll
        for (int b = 0; b < 2; ++b)
#pragma unroll
            for (int m = 0; m < 4; ++m)
#pragma unroll
                for (int n = 0; n < 2; ++n) acc[a][b][m][n] = (f32x4){0.f, 0.f, 0.f, 0.f};
    bf16x8 At[4][2], B0[2][2], B1[2][2];
    const char* cA = (const char*)g.A + (size_t)cur.pm * tstep; const char* cB = (const char*)g.Bt + (size_t)cur.pn * tstep;
    S.a_ready(cur);
    PG8_STAGE(PG8_SB(0, 0), cB, voffB); PG8_STAGE(PG8_SA(0, 0), cA, voffA); PG8_STAGE(PG8_SB(0, 1), cB + hstep, voffB); PG8_STAGE(PG8_SA(0, 1), cA + hstep, voffA);
    if (wr == 1) PG8_BAR;
    PG8_WAIT_V(4); PG8_BAR;
    PG8_STAGE(PG8_SB(1, 0), cB + kstep, voffB); PG8_STAGE(PG8_SA(1, 0), cA + kstep, voffA); PG8_STAGE(PG8_SB(1, 1), cB + hstep + kstep, voffB);
    PG8_WAIT_V(6); PG8_BAR;
    PG8_STAMP();
    for (;;) {
        const bool has_next = S.next(ui + 1, nxt);
        const char* nA = has_next ? (const char*)g.A + (size_t)nxt.pm * tstep : cA; const char* nB = has_next ? (const char*)g.Bt + (size_t)nxt.pn * tstep : cB;
        for (int t = 0; t < nt; t += 2) {
            const bool last = (t == nt - 2);
            const char* a1 = cA + (size_t)(t + 1) * kstep;
            const char* a2 = last ? nA : cA + (size_t)(t + 2) * kstep; const char* b2 = last ? nB : cB + (size_t)(t + 2) * kstep;
            const char* a3 = a2 + kstep; const char* b3 = b2 + kstep;
            if (last && has_next) S.a_ready(nxt);
            PG8_LDB(B0, 0, 0); PG8_SCHED; PG8_LDA(At, 0, 0); PG8_STAGE(PG8_SA(1, 1), a1 + hstep, voffA);
            PG8_WAIT_L(8); PG8_BAR; PG8_WAIT_L(0); PG8_MMA(0, 0, At, B0); PG8_BAR; PG8_SCHED;
            PG8_LDB(B1, 0, 1); PG8_STAGE(PG8_SB(0, 0), b2, voffB);
            PG8_BAR; PG8_WAIT_L(0); PG8_MMA(0, 1, At, B1); PG8_BAR;
            PG8_LDA(At, 0, 1); PG8_STAGE(PG8_SA(0, 0), a2, voffA);
            PG8_BAR; PG8_WAIT_L(0); PG8_MMA(1, 0, At, B0); PG8_BAR; PG8_SCHED;
            PG8_STAGE(PG8_SB(0, 1), b2 + hstep, voffB);
            PG8_WAIT_V(6); PG8_BAR; PG8_MMA(1, 1, At, B1); PG8_BAR;
            PG8_LDB(B0, 1, 0); PG8_SCHED; PG8_LDA(At, 1, 0); PG8_STAGE(PG8_SA(0, 1), a2 + hstep, voffA);
            PG8_WAIT_L(8); PG8_BAR; PG8_WAIT_L(0); PG8_MMA(0, 0, At, B0); PG8_BAR; PG8_SCHED;
            PG8_LDB(B1, 1, 1); PG8_STAGE(PG8_SB(1, 0), b3, voffB);
            PG8_BAR; PG8_WAIT_L(0); PG8_MMA(0, 1, At, B1); PG8_BAR;
            PG8_LDA(At, 1, 1); PG8_STAGE(PG8_SA(1, 0), a3, voffA);
            PG8_BAR; PG8_WAIT_L(0); PG8_MMA(1, 0, At, B0); PG8_BAR; PG8_SCHED;
            PG8_STAGE(PG8_SB(1, 1), b3 + hstep, voffB);
            PG8_WAIT_V(6); PG8_BAR; PG8_MMA(1, 1, At, B1); PG8_BAR;
        }
        PG8_STAMP();
        if constexpr (!Epi::AFTER_DRAIN) { E(acc, cur, wr, wc, fr, fq); S.done(cur); }
        PG8_STAMP();
        if (!has_next) break;
#pragma unroll
        for (int a = 0; a < 2; ++a)
#pragma unroll
            for (int b = 0; b < 2; ++b)
#pragma unroll
                for (int m = 0; m < 4; ++m)
#pragma unroll
                    for (int n = 0; n < 2; ++n) acc[a][b][m][n] = (f32x4){0.f, 0.f, 0.f, 0.f};
        cur = nxt; cA = nA; cB = nB; ++ui;
    }
    PG8_WAIT_V(0);
    if (wr == 0) PG8_BAR;
    PG8_BAR;
    if constexpr (Epi::AFTER_DRAIN) { E.fused(acc, cur, wr, wc, fr, fq, lds, wid, lane); S.done(cur); }
    PG8_STAMP();
    if (STAMP && wid == 0) { stamps[lane] = lane < nts ? (((unsigned long long)(unsigned)ts_hi << 32) | (unsigned)ts_lo) : 0ull;
        if (lane == 62) stamps[62] = rt_entry; if (lane == 63) stamps[63] = (unsigned long long)wall_clock64(); }
#undef PG8_STAMP
#undef PG8_SA
#undef PG8_SB
#undef PG8_STAGE
#undef PG8_LDA
#undef PG8_LDB
#undef PG8_MMA
#undef PG8_WAIT_V
#undef PG8_WAIT_L
#undef PG8_BAR
#undef PG8_SCHED
}
}

struct EpiSwiglu {
  static constexpr bool PERM = true, AFTER_DRAIN = false;
  u16* O;
  DI void operator()(const f32x4 (&acc)[2][2][4][2], const pg8::Unit& u, int wr, int wc, int fr, int fq) const {
    const int row0 = u.pm * 256 + wr * 64 + fr, col0 = u.pn * 128 + wc * 32 + 8 * fq;
#pragma unroll
    for (int ai = 0; ai < 2; ++ai)
#pragma unroll
      for (int m = 0; m < 4; ++m) {
        u16* rowp = O + (size_t)(row0 + ai * 128 + m * 16) * DFF + col0;
        f32x4 g0 = acc[ai][0][m][0], g1 = acc[ai][0][m][1], u0 = acc[ai][1][m][0], u1 = acc[ai][1][m][1];
        float v[8];
#pragma unroll
        for (int j = 0; j < 4; ++j) { v[j] = siluf_(g0[j]) * u0[j]; v[4 + j] = siluf_(g1[j]) * u1[j]; }
        u32x4 w; w.x = pg8::cvt_pk_bf16(v[0], v[1]); w.y = pg8::cvt_pk_bf16(v[2], v[3]); w.z = pg8::cvt_pk_bf16(v[4], v[5]); w.w = pg8::cvt_pk_bf16(v[6], v[7]);
        *(u32x4*)rowp = w;
      }
  }
};
struct EpiResid {
  static constexpr bool PERM = false, AFTER_DRAIN = false;
  const Params& P; int gate_off; float gs; int mode; int ln_off;
  DI void operator()(const f32x4 (&acc)[2][2][4][2], const pg8::Unit& u, int wr, int wc, int fr, int fq) const {
    const int row0 = u.pm * 256 + wr * 64 + fr, col0 = u.pn * 256 + wc * 32 + 4 * fq;
    const float* gate = P.mod + gate_off; const float* lng = P.ln_g + ln_off; const float* lnb = P.ln_b + ln_off;
#pragma unroll
    for (int ai = 0; ai < 2; ++ai)
#pragma unroll
      for (int m = 0; m < 4; ++m) {
        const int r = row0 + ai * 128 + m * 16;
        const float* xr = (mode == 0) ? (r < NCTX ? P.x_prompt + (size_t)r * 1024 : P.x_sample + (size_t)(r - NCTX) * 1024) : P.X + (size_t)r * 1024;
        const float* gr = gate + (size_t)mrow_of(r) * 9216;
        float* orow = P.X + (size_t)r * 1024;
        float mean = 0.f, rstd = 1.f;
        if (mode == 2) { const float2 ms = *(const float2*)(P.ST + 2 * (size_t)r); mean = ms.x; rstd = ms.y; }
#pragma unroll
        for (int bj = 0; bj < 2; ++bj)
#pragma unroll
          for (int n = 0; n < 2; ++n) {
            const int c = col0 + bj * 128 + n * 16;
            f32x4 x4 = *(const f32x4*)(xr + c); const f32x4 g4 = *(const f32x4*)(gr + c);
            if (mode == 2) x4 = (x4 - mean) * rstd * *(const f32x4*)(lng + c) + *(const f32x4*)(lnb + c);
            *(f32x4*)(orow + c) = x4 * ALPHA_F + (g4 * gs) * acc[ai][bj][m][n];
          }
        asm volatile("" ::: "memory");
      }
  }
};
struct EpiP {
  static constexpr bool PERM = true, AFTER_DRAIN = false;
  u16* R1; float* nak; float* nav; int l;
  DI void operator()(const f32x4 (&acc)[2][2][4][2], const pg8::Unit& u, int wr, int wc, int fr, int fq) const {
    u16* base; int ldc, colt;
    if (u.pn < 4) { base = R1; ldc = 1024; colt = u.pn * 256; }
    else if (u.pn == 4) { base = R1 + (size_t)MTOK * 1024; ldc = 256; colt = 0; }
    else if (u.pn < 10) { base = R1 + (size_t)MTOK * 1280; ldc = 1280; colt = (u.pn - 5) * 256; }
    else { base = R1 + (size_t)MTOK * 2560; ldc = 768; colt = (u.pn - 10) * 256; }
    const int row0 = u.pm * 256 + wr * 64 + fr, cw = wc * 32 + 8 * fq;
    float* fdst = (u.pn == 11) ? nak : nav;
    const bool wf = (u.pn >= 11) && (u.pm < 32);
#pragma unroll
    for (int ai = 0; ai < 2; ++ai)
#pragma unroll
      for (int m = 0; m < 4; ++m) {
        const int r = row0 + ai * 128 + m * 16;
        u16* rowp = base + (size_t)r * ldc + colt + cw;
#pragma unroll
        for (int bj = 0; bj < 2; ++bj) {
          const f32x4 v0 = acc[ai][bj][m][0], v1 = acc[ai][bj][m][1];
          u32x4 w; w.x = pg8::cvt_pk_bf16(v0[0], v0[1]); w.y = pg8::cvt_pk_bf16(v0[2], v0[3]); w.z = pg8::cvt_pk_bf16(v1[0], v1[1]); w.w = pg8::cvt_pk_bf16(v1[2], v1[3]);
          *(u32x4*)(rowp + bj * 128) = w;
          if (wf) {
            float* fp = fdst + ((size_t)(((r >> 8) * 2 + l) * 256 + (r & 255))) * 256 + bj * 128 + cw;
            *(f32x4*)fp = v0; *(f32x4*)(fp + 4) = v1;
          }
        }
      }
  }
};

template <class Epi>
DI void run_gemm(PG8_LAS unsigned char* lds, const u16* A, const u16* Bt, int M, int N, int K, const Epi& E) {
  pg8::Gemm g; g.A = A; g.Bt = Bt; g.M = M; g.N = N; g.K = K;
  pg8::StaticOrder S; S.init(M, N, (int)gridDim.x, (int)blockIdx.x);
  pg8::gemm_phase<Epi, pg8::StaticOrder, false>(lds, g, S, E, nullptr);
}

#define NCONV 5348
struct ConvJob { const float* src; u16* dst; int K, N, perm, tile; };
DI ConvJob conv_decode(const Params& P, int l, int job) {
  ConvJob j;
  if (job < 1408) { j.src = P.ffn_w_in + (size_t)(l * 2 + 0) * 1024 * 5632; j.dst = P.WA0; j.K = 1024; j.N = 5632; j.perm = 1; j.tile = job; }
  else if (job < 2816) { j.src = P.ffn_w_in + (size_t)(l * 2 + 1) * 1024 * 5632; j.dst = P.WA1; j.K = 1024; j.N = 5632; j.perm = 1; j.tile = job - 1408; }
  else if (job < 3520) { j.src = P.ffn_w_out + (size_t)(l * 2 + 0) * DFF * 1024; j.dst = P.WB0; j.K = DFF; j.N = 1024; j.perm = 0; j.tile = job - 2816; }
  else if (job < 4224) { j.src = P.ffn_w_out + (size_t)(l * 2 + 1) * DFF * 1024; j.dst = P.WB1; j.K = DFF; j.N = 1024; j.perm = 0; j.tile = job - 3520; }
  else if (job < 5056) { j.src = P.w_in + (size_t)l * 1024 * 3328; j.dst = P.WC; j.K = 1024; j.N = 3328; j.perm = 0; j.tile = job - 4224; }
  else if (job < 5312) { j.src = P.w_out + (size_t)l * 1024 * 1024; j.dst = P.WD; j.K = 1024; j.N = 1024; j.perm = 0; j.tile = job - 5056; }
  else if (job < 5328) { j.src = P.s5_glu_w + (size_t)l * 256 * 256; j.dst = P.WGLU; j.K = 256; j.N = 256; j.perm = 0; j.tile = job - 5312; }
  else if (job < 5336) { j.src = P.rw_g_up + (size_t)l * 128 * 256; j.dst = P.WGUP; j.K = 128; j.N = 256; j.perm = 0; j.tile = job - 5328; }
  else if (job < 5340) { j.src = P.rw_a_up + (size_t)l * 64 * 256; j.dst = P.WAUP; j.K = 64; j.N = 256; j.perm = 0; j.tile = job - 5336; }
  else if (job < 5344) { j.src = P.rw_w_up + (size_t)(l * 2 + 0) * 64 * 256; j.dst = P.WWUP0; j.K = 64; j.N = 256; j.perm = 0; j.tile = job - 5340; }
  else { j.src = P.rw_w_up + (size_t)(l * 2 + 1) * 64 * 256; j.dst = P.WWUP1; j.K = 64; j.N = 256; j.perm = 0; j.tile = job - 5344; }
  return j;
}
DI void conv_load(const ConvJob& j, int tidc, float (&v)[8]) {
  const int nK = j.K >> 6; const int nt = j.tile / nK, kt = j.tile - nt * nK;
  const int tx = tidc & 63, ty = tidc >> 6;
  const int np = nt * 64 + tx; int sc = np;
  if (j.perm) { const int t = np >> 8, c = np & 255; sc = (c < 128) ? (t * 128 + c) : (DFF + t * 128 + (c - 128)); }
#pragma unroll
  for (int i = 0; i < 8; ++i) v[i] = j.src[(size_t)(kt * 64 + ty + 8 * i) * j.N + sc];
}
DI void conv_store(const ConvJob& j, int tidc, const float (&v)[8], float* tl) {
  const int nK = j.K >> 6; const int nt = j.tile / nK, kt = j.tile - nt * nK;
  const int tx = tidc & 63, ty = tidc >> 6;
#pragma unroll
  for (int i = 0; i < 8; ++i) tl[(ty + 8 * i) * 65 + tx] = v[i];
  __syncthreads();
  const int r = tidc >> 3, c0 = (tidc & 7) * 8;
  u32x4 w;
  w.x = pk2(tl[(c0 + 0) * 65 + r], tl[(c0 + 1) * 65 + r]); w.y = pk2(tl[(c0 + 2) * 65 + r], tl[(c0 + 3) * 65 + r]);
  w.z = pk2(tl[(c0 + 4) * 65 + r], tl[(c0 + 5) * 65 + r]); w.w = pk2(tl[(c0 + 6) * 65 + r], tl[(c0 + 7) * 65 + r]);
  *(u32x4*)(j.dst + (size_t)(nt * 64 + r) * j.K + kt * 64 + c0) = w;
  __syncthreads();
}
DI void convert_all(const Params& P, int l, float* tl) {
  const int tidc = ltid();
  int job = blockIdx.x;
  if (job >= NCONV) return;
  ConvJob cur = conv_decode(P, l, job);
  float va[8], vb[8];
  conv_load(cur, tidc, va);
  for (;;) {
    const int j1 = job + gridDim.x;
    ConvJob n1 = cur; if (j1 < NCONV) { n1 = conv_decode(P, l, j1); conv_load(n1, tidc, vb); }
    conv_store(cur, tidc, va, tl);
    if (j1 >= NCONV) break;
    const int j2 = j1 + gridDim.x;
    ConvJob n2 = n1; if (j2 < NCONV) { n2 = conv_decode(P, l, j2); conv_load(n2, tidc, va); }
    conv_store(n1, tidc, vb, tl);
    if (j2 >= NCONV) break;
    cur = n2; job = j2;
  }
}
DI void phase_p0(const Params& P, unsigned char* lds) {
  float* tl = (float*)lds;
  float* sc = (float*)(lds + 16640);
  float* red = (float*)(lds + 16640 + 36864);
  const int tid = ltid();
  if (blockIdx.x == 0 && tid < 4) P.qctr[tid] = 0u;
  for (int i = tid; i < 9216; i += NTHR) { const int r = i >> 10, k = i & 1023; const float v = (r == 0) ? P.c_ctx[k] : P.c[(r - 1) * 1024 + k]; sc[i] = siluf_(v); }
  __syncthreads();
  convert_all(P, 0, tl);
  for (int jm = (blockIdx.x + 100) % gridDim.x; jm < 288; jm += gridDim.x) {
    const int l = jm / 144, col0 = (jm % 144) * 64;
    const int col = tid & 63, kg = tid >> 6;
    float acc[9];
#pragma unroll
    for (int r = 0; r < 9; ++r) acc[r] = 0.f;
    const float* wp = P.w_mod + (size_t)l * 1024 * 9216 + col0 + col;
    for (int k0 = kg * 128; k0 < kg * 128 + 128; k0 += 16) {
      float w[16];
#pragma unroll
      for (int i = 0; i < 16; ++i) w[i] = wp[(size_t)(k0 + i) * 9216];
#pragma unroll
      for (int i = 0; i < 16; ++i)
#pragma unroll
        for (int r = 0; r < 9; ++r) acc[r] += sc[r * 1024 + k0 + i] * w[i];
    }
#pragma unroll
    for (int r = 0; r < 9; ++r) red[(kg * 9 + r) * 64 + col] = acc[r];
    __syncthreads();
    for (int i = tid; i < 576; i += NTHR) {
      const int r = i >> 6, cc = i & 63; float s = P.b_mod[l * 9216 + col0 + cc];
#pragma unroll
      for (int g = 0; g < 8; ++g) s += red[(g * 9 + r) * 64 + cc];
      P.mod[(size_t)(l * 9 + r) * 9216 + col0 + cc] = s;
    }
    __syncthreads();
  }
}

DI void phase_lnmod(const Params& P, const float* lng, const float* lnb, const float* modl, int shoff, int from_input, int writeX) {
  const int tidl = ltid(); const int wid = tidl >> 6, lane = tidl & 63;
  for (int m = blockIdx.x * 8 + wid; m < MTOK; m += gridDim.x * 8) {
    const float* src = from_input ? (m < NCTX ? P.x_prompt + (size_t)m * 1024 : P.x_sample + (size_t)(m - NCTX) * 1024) : P.X + (size_t)m * 1024;
    f32x4 v[4];
#pragma unroll
    for (int i = 0; i < 4; ++i) v[i] = *(const f32x4*)(src + lane * 4 + 256 * i);
    if (lng) {
      float s = 0.f;
#pragma unroll
      for (int i = 0; i < 4; ++i) s += (v[i][0] + v[i][1]) + (v[i][2] + v[i][3]);
      s = wave_sum(s); const float mean = s * (1.0f / 1024.0f);
      float q = 0.f;
#pragma unroll
      for (int i = 0; i < 4; ++i) { const f32x4 d = v[i] - mean; q += (d[0] * d[0] + d[1] * d[1]) + (d[2] * d[2] + d[3] * d[3]); }
      q = wave_sum(q); const float rstd = 1.0f / sqrtf(q * (1.0f / 1024.0f) + 1e-5f);
#pragma unroll
      for (int i = 0; i < 4; ++i) {
        const int c = lane * 4 + 256 * i;
        const f32x4 g = *(const f32x4*)(lng + c), b = *(const f32x4*)(lnb + c);
        v[i] = (v[i] - mean) * rstd * g + b;
        if (writeX) *(f32x4*)(P.X + (size_t)m * 1024 + c) = v[i];
      }
      if (!writeX && lane == 0) *(float2*)(P.ST + 2 * (size_t)m) = make_float2(mean, rstd);
    }
    if (modl) {
      const float* mr = modl + (size_t)mrow_of(m) * 9216 + shoff * 1024;
#pragma unroll
      for (int i = 0; i < 4; ++i) {
        const int c = lane * 4 + 256 * i;
        const f32x4 sh = *(const f32x4*)(mr + c), scl = *(const f32x4*)(mr + 1024 + c);
        const f32x4 h = v[i] * (scl + 1.0f) + sh;
        u32x2 w; w.x = pk2(h[0], h[1]); w.y = pk2(h[2], h[3]);
        *(u32x2*)(P.H + (size_t)m * 1024 + c) = w;
      }
    }
  }
}

DI void phase_prep(const Params& P, int l, unsigned char* lds) {
  u16* Atw = (u16*)lds;
  u16* Aad = Atw + 32 * 72;
  const int tid = ltid(); const int wid = tid >> 6, lane = tid & 63, fr = lane & 15, fq = lane >> 4;
  const float* mu_p = P.rw_mu + (size_t)(l * 2 + 0) * 1024, *mu_n = P.rw_mu + (size_t)(l * 2 + 1) * 1024;
  bf16x8 bw[3][2][2];
#pragma unroll
  for (int nt = 0; nt < 2; ++nt)
#pragma unroll
    for (int ks = 0; ks < 2; ++ks) {
      const size_t o = (size_t)(wid * 32 + nt * 16 + fr) * 64 + ks * 32 + fq * 8;
      bw[0][nt][ks] = *(const bf16x8*)(P.WAUP + o); bw[1][nt][ks] = *(const bf16x8*)(P.WWUP0 + o); bw[2][nt][ks] = *(const bf16x8*)(P.WWUP1 + o);
    }
  float bias[3][2];
#pragma unroll
  for (int nt = 0; nt < 2; ++nt) { const int n = wid * 32 + nt * 16 + fr; bias[0][nt] = P.rw_a0[l * 256 + n]; bias[1][nt] = P.rw_w0[(l * 2 + 0) * 256 + n]; bias[2][nt] = P.rw_w0[(l * 2 + 1) * 256 + n]; }
  for (int g = blockIdx.x * NTHR + tid; g < 65536; g += gridDim.x * NTHR) {
    const size_t so = (size_t)(((g >> 13) * 2 + l)) * 65536 + (size_t)(g & 8191) * 8;
    const f32x4 k0 = *(const f32x4*)(P.cache_k + so), k1 = *(const f32x4*)(P.cache_k + so + 4), v0 = *(const f32x4*)(P.cache_v + so), v1 = *(const f32x4*)(P.cache_v + so + 4);
    u32x4 wk, wv; wk.x = pk2(k0[0], k0[1]); wk.y = pk2(k0[2], k0[3]); wk.z = pk2(k1[0], k1[1]); wk.w = pk2(k1[2], k1[3]);
    wv.x = pk2(v0[0], v0[1]); wv.y = pk2(v0[2], v0[3]); wv.z = pk2(v1[0], v1[1]); wv.w = pk2(v1[2], v1[3]);
    *(u32x4*)(P.KC + (size_t)g * 8) = wk; *(u32x4*)(P.VC + (size_t)g * 8) = wv;
  }
  for (int job = blockIdx.x; job < MTOK / 32; job += gridDim.x) {
    const int m0 = job * 32;
    {
      const int t = tid >> 4, cg = tid & 15; const int m = m0 + t;
      int start, len; const int s = m < NCTX ? (m >> 8) : 32 + ((m - NCTX) >> 12); seq_info(s, start, len);
      const int tt = m - start; const int col = 768 + cg * 8;
      const u16* p0 = P.R1 + (size_t)m * 1024 + col;
      u32x4 c = *(const u32x4*)p0, pv = {0, 0, 0, 0}, nx = {0, 0, 0, 0};
      if (tt > 0) pv = *(const u32x4*)(p0 - 1024);
      if (tt < len - 1) nx = *(const u32x4*)(p0 + 1024);
      float sh[8];
#pragma unroll
      for (int i = 0; i < 8; ++i) {
        const unsigned cw = c[i >> 1], pw = pv[i >> 1], nw = nx[i >> 1];
        const float x = (i & 1) ? bfhi(cw) : bflo(cw), xp = (i & 1) ? bfhi(pw) : bflo(pw), xn = (i & 1) ? bfhi(nw) : bflo(nw);
        const float v = x + mu_p[col + i] * (xp - x) + mu_n[col + i] * (xn - x);
        sh[i] = (cg < 8) ? tanhf(v) : v;
      }
      u32x4 w; w.x = pk2(sh[0], sh[1]); w.y = pk2(sh[2], sh[3]); w.z = pk2(sh[4], sh[5]); w.w = pk2(sh[6], sh[7]);
      *(u32x4*)(((cg < 8) ? Atw : Aad) + t * 72 + (cg & 7) * 8) = w;
    }
    __syncthreads();
#pragma unroll
    for (int mt = 0; mt < 2; ++mt) {
      bf16x8 atw[2], aad[2];
#pragma unroll
      for (int ks = 0; ks < 2; ++ks) { atw[ks] = *(const bf16x8*)(Atw + (mt * 16 + fr) * 72 + ks * 32 + fq * 8); aad[ks] = *(const bf16x8*)(Aad + (mt * 16 + fr) * 72 + ks * 32 + fq * 8); }
#pragma unroll
      for (int nt = 0; nt < 2; ++nt) {
        f32x4 ca = {0.f, 0.f, 0.f, 0.f}, c0 = ca, c1 = ca;
#pragma unroll
        for (int ks = 0; ks < 2; ++ks) {
          ca = __builtin_amdgcn_mfma_f32_16x16x32_bf16(aad[ks], bw[0][nt][ks], ca, 0, 0, 0);
          c0 = __builtin_amdgcn_mfma_f32_16x16x32_bf16(atw[ks], bw[1][nt][ks], c0, 0, 0, 0);
          c1 = __builtin_amdgcn_mfma_f32_16x16x32_bf16(atw[ks], bw[2][nt][ks], c1, 0, 0, 0);
        }
        const int n = wid * 32 + nt * 16 + fr;
#pragma unroll
        for (int j = 0; j < 4; ++j) {
          const size_t o = (size_t)(m0 + mt * 16 + fq * 4 + j) * 256 + n;
          P.PA[o] = f2bf(sigmoidf_(bias[0][nt] + ca[j]));
          P.PE0[o] = f2bf(0.60653066f * sigmoidf_(bias[1][nt] + c0[j]));
          P.PE1[o] = f2bf(0.60653066f * sigmoidf_(bias[2][nt] + c1[j]));
        }
      }
    }
    __syncthreads();
  }
}

DI void rwkv_unit(const Params& P, int l, int s, int h, int d, int half, unsigned char* lds) {
  int tid = threadIdx.x; asm volatile("" : "+v"(tid)); const int wid = tid >> 6, lane = tid & 63;
  const int rowl = (wid & 3) * 8 + (lane >> 3), row = half * 32 + rowl, kq = lane & 7;
  int start, len; seq_info(s, start, len);
  float* buf = (float*)lds;
  float* yst = buf + 2 * 6 * 1024;
  f32x2 S2[4];
  if (s >= 32) {
    const float* sp = P.st_rwkv + ((((size_t)(s - 32) * 2 + l) * 2 + d) * 4 + h) * 4096 + row * 64 + kq * 8;
    const f32x4 a = *(const f32x4*)sp, bq = *(const f32x4*)(sp + 4);
    S2[0] = lo2(a); S2[1] = hi2(a); S2[2] = lo2(bq); S2[3] = hi2(bq);
  } else {
#pragma unroll
    for (int i = 0; i < 4; ++i) S2[i] = (f32x2){0.f, 0.f};
  }
  const int ptok = tid >> 5, pc = (tid & 31) * 2;
  float mup[3][2], mun[3][2];
#pragma unroll
  for (int k = 0; k < 3; ++k)
#pragma unroll
    for (int e = 0; e < 2; ++e) { mup[k][e] = P.rw_mu[(size_t)(l * 2 + 0) * 1024 + k * 256 + h * 64 + pc + e]; mun[k][e] = P.rw_mu[(size_t)(l * 2 + 1) * 1024 + k * 256 + h * 64 + pc + e]; }
  const float kk0 = P.rw_k_k[l * 256 + h * 64 + pc], kk1 = P.rw_k_k[l * 256 + h * 64 + pc + 1];
  const float ka0 = P.rw_k_a[l * 256 + h * 64 + pc], ka1 = P.rw_k_a[l * 256 + h * 64 + pc + 1];
  const u16* pe = d ? P.PE1 : P.PE0;
  u16* outp = d ? P.YB : P.H; const int ldo = d ? 256 : 1024;
  const int nch = len >> 4;
  unsigned rawA[11], rawB[11], rawC[11], rawD[11];
#define RW_ISSUE(ci, raw) do { const int t0_ = d ? (len - 16 - (ci) * 16) : (ci) * 16; const int t_ = t0_ + ptok; const size_t m_ = (size_t)(start + t_); \
    _Pragma("unroll") for (int k_ = 0; k_ < 3; ++k_) { const u16* p_ = P.R1 + m_ * 1024 + k_ * 256 + h * 64 + pc; \
      raw[k_ * 3 + 0] = (t_ > 0) ? *(const unsigned*)(p_ - 1024) : 0u; raw[k_ * 3 + 1] = *(const unsigned*)p_; raw[k_ * 3 + 2] = (t_ < len - 1) ? *(const unsigned*)(p_ + 1024) : 0u; } \
    raw[9] = *(const unsigned*)(P.PA + m_ * 256 + h * 64 + pc); raw[10] = *(const unsigned*)(pe + m_ * 256 + h * 64 + pc); } while (0)
#define RW_FLUSH(ci, b) do { const int t0_ = d ? (len - 16 - (ci) * 16) : (ci) * 16; \
    outp[(size_t)(start + t0_ + ptok) * ldo + h * 64 + half * 32 + (tid & 31)] = f2bf(yst[(b) * 1024 + ptok * 64 + (tid & 31)]); } while (0)
  RW_ISSUE(0, rawA); RW_ISSUE(1, rawB); RW_ISSUE(2, rawC); RW_ISSUE(3, rawD);
  auto body = [&](unsigned (&raw)[11], const int ci, const int b) __attribute__((always_inline)) {
    {
      float sh[3][2];
#pragma unroll
      for (int k = 0; k < 3; ++k) {
        const unsigned pw = raw[k * 3], cw = raw[k * 3 + 1], nw = raw[k * 3 + 2];
        const float c0 = bflo(cw), c1 = bfhi(cw);
        sh[k][0] = c0 + mup[k][0] * (bflo(pw) - c0) + mun[k][0] * (bflo(nw) - c0);
        sh[k][1] = c1 + mup[k][1] * (bfhi(pw) - c1) + mun[k][1] * (bfhi(nw) - c1);
      }
      const float a0 = bflo(raw[9]), a1 = bfhi(raw[9]), e0 = bflo(raw[10]), e1 = bfhi(raw[10]);
      const float q0 = sh[1][0] * kk0, q1 = sh[1][1] * kk1;
      float ss = q0 * q0 + q1 * q1;
      ss = hsum32(ss);
      const float inv = 1.0f / fmaxf(sqrtf(ss), 1e-12f);
      const float n0 = q0 * inv, n1 = q1 * inv;
      float* B = buf + b * 6144 + ptok * 64 + pc;
      *(float2*)(B + 0 * 1024) = make_float2(sh[0][0], sh[0][1]);
      *(float2*)(B + 1 * 1024) = make_float2(__expf(-e0), __expf(-e1));
      *(float2*)(B + 2 * 1024) = make_float2(sh[1][0] * (1.f + (a0 - 1.f) * ka0), sh[1][1] * (1.f + (a1 - 1.f) * ka1));
      *(float2*)(B + 3 * 1024) = make_float2(sh[2][0], sh[2][1]);
      *(float2*)(B + 4 * 1024) = make_float2(n0, n1);
      *(float2*)(B + 5 * 1024) = make_float2(n0 * a0, n1 * a1);
    }
    asm volatile("s_waitcnt lgkmcnt(0)" ::: "memory"); __builtin_amdgcn_s_barrier(); asm volatile("" ::: "memory");
    if ((ci) > 0) RW_FLUSH((ci) - 1, (b) ^ 1);
    if ((ci) + 4 < nch) RW_ISSUE((ci) + 4, raw);
    if (wid < 4) {
      struct Ops { f32x4 r0, r1, w0, w1, k0, k1, c0, c1, b0, b1; float vv; };
#define RW_LD(o, st_) do { const int tt_ = d ? 15 - (st_) : (st_); const float* B_ = buf + b * 6144 + tt_ * 64 + kq * 8; \
        o.r0 = *(const f32x4*)(B_); o.r1 = *(const f32x4*)(B_ + 4); o.w0 = *(const f32x4*)(B_ + 1024); o.w1 = *(const f32x4*)(B_ + 1028); \
        o.k0 = *(const f32x4*)(B_ + 2048); o.k1 = *(const f32x4*)(B_ + 2052); o.c0 = *(const f32x4*)(B_ + 4096); o.c1 = *(const f32x4*)(B_ + 4100); \
        o.b0 = *(const f32x4*)(B_ + 5120); o.b1 = *(const f32x4*)(B_ + 5124); o.vv = buf[b * 6144 + 3072 + tt_ * 64 + row]; } while (0)
      Ops ring[2];
      RW_LD(ring[0], 0);
      __builtin_amdgcn_sched_group_barrier(0x100, 11, 0);
      float ykeep = 0.f;
      f32x4 pr0 = {0.f, 0.f, 0.f, 0.f}, pr1 = pr0;
#pragma unroll
      for (int st = 0; st < 16; ++st) {
        if (st < 15) RW_LD(ring[(st + 1) % 2], st + 1);
        const Ops& cur = ring[st % 2];
        const f32x2 a0 = S2[0] * lo2(cur.c0) + S2[1] * hi2(cur.c0), a1 = S2[2] * lo2(cur.c1) + S2[3] * hi2(cur.c1);
        const f32x2 a2 = a0 + a1;
        float ysum = 0.f;
        if (st > 0) { const f32x2 y0 = S2[0] * lo2(pr0) + S2[1] * hi2(pr0), y1 = S2[2] * lo2(pr1) + S2[3] * hi2(pr1); const f32x2 y2 = y0 + y1; ysum = y2[0] + y2[1]; }
        const float sa = -red8(a2[0] + a2[1]);
        if (st > 0) { const float yv = red8(ysum); ykeep = (kq == ((st - 1) & 7)) ? yv : ykeep;
          if (((st - 1) & 7) == 7) { const int tk = ((st - 1) & 8) + kq; yst[b * 1024 + (d ? 15 - tk : tk) * 64 + rowl] = ykeep; } }
        const f32x2 sa2 = {sa, sa}, vv2 = {cur.vv, cur.vv};
        S2[0] = S2[0] * lo2(cur.w0) + (sa2 * lo2(cur.b0) + vv2 * lo2(cur.k0));
        S2[1] = S2[1] * hi2(cur.w0) + (sa2 * hi2(cur.b0) + vv2 * hi2(cur.k0));
        S2[2] = S2[2] * lo2(cur.w1) + (sa2 * lo2(cur.b1) + vv2 * lo2(cur.k1));
        S2[3] = S2[3] * hi2(cur.w1) + (sa2 * hi2(cur.b1) + vv2 * hi2(cur.k1));
        pr0 = cur.r0; pr1 = cur.r1;
        __builtin_amdgcn_sched_group_barrier(0x100, 11, 0);
        __builtin_amdgcn_sched_group_barrier(0x002, 34, 0);
      }
      { const f32x2 y0 = S2[0] * lo2(pr0) + S2[1] * hi2(pr0), y1 = S2[2] * lo2(pr1) + S2[3] * hi2(pr1); const f32x2 y2 = y0 + y1;
        const float yv = red8(y2[0] + y2[1]); ykeep = (kq == 7) ? yv : ykeep; const int tk = 8 + kq; yst[b * 1024 + (d ? 15 - tk : tk) * 64 + rowl] = ykeep; }
#undef RW_LD
    }
  };
  for (int ci2 = 0; ci2 < nch; ci2 += 4) { body(rawA, ci2, 0); body(rawB, ci2 + 1, 1); body(rawC, ci2 + 2, 0); body(rawD, ci2 + 3, 1); }
  __syncthreads();
  RW_FLUSH(nch - 1, (nch - 1) & 1);
  if (s < 32) {
    float* op = P.o_rwkv + ((((size_t)s * 2 + l) * 2 + d) * 4 + h) * 4096 + row * 64 + kq * 8;
    if (wid < 4) { *(f32x4*)op = (f32x4){S2[0][0], S2[0][1], S2[1][0], S2[1][1]}; *(f32x4*)(op + 4) = (f32x4){S2[2][0], S2[2][1], S2[3][0], S2[3][1]}; }
  }
  __syncthreads();
#undef RW_ISSUE
#undef RW_FLUSH
}

DI void hgrn_unit(const Params& P, int l, int s, int h, int d, int half, unsigned char* lds) {
  int tid = threadIdx.x; asm volatile("" : "+v"(tid)); const int wid = tid >> 6, lane = tid & 63;
  const int coll = wid * 8 + (lane >> 3), col = coll, kq = lane & 7;
  int start, len; seq_info(s, start, len);
  float* buf = (float*)lds;
  float* yst = buf + 2 * 4 * 1024;
  f32x2 S2[4];
  if (s >= 32) {
    const float* sp = P.st_hgrn + ((((size_t)(s - 32) * 2 + l) * 2 + d) * 4 + h) * 4096;
#pragma unroll
    for (int i = 0; i < 4; ++i) S2[i] = (f32x2){sp[(kq * 8 + 2 * i) * 64 + col], sp[(kq * 8 + 2 * i + 1) * 64 + col]};
  } else {
#pragma unroll
    for (int i = 0; i < 4; ++i) S2[i] = (f32x2){0.f, 0.f};
  }
  const int ptok = tid >> 5, pc = (tid & 31) * 2;
  float lb0 = 0.f, lb1 = 0.f;
  if (l == 1) {
    const float h00 = P.hg_lb[h * 64 + pc], h01 = P.hg_lb[h * 64 + pc + 1], h10 = P.hg_lb[256 + h * 64 + pc], h11 = P.hg_lb[256 + h * 64 + pc + 1];
    lb0 = 1.0f / (1.0f + expf(h00 - h10)); lb1 = 1.0f / (1.0f + expf(h01 - h11));
  }
  const u16* pC = P.R1 + (size_t)MTOK * 1280;
  u16* outp = d ? (P.YB + (size_t)MTOK * 512) : P.H; const int ldo = d ? 256 : 1024; const int coff = d ? 0 : 512;
  const int nch = len >> 4;
  unsigned rawA[3], rawB[3], rawC[3], rawD[3];
#define HG_ISSUE(ci, raw) do { const int t0_ = d ? (len - 16 - (ci) * 16) : (ci) * 16; const u16* p_ = pC + (size_t)(start + t0_ + ptok) * 1280 + h * 64 + pc; \
    raw[0] = *(const unsigned*)p_; raw[1] = *(const unsigned*)(p_ + 256 * (1 + d)); raw[2] = *(const unsigned*)(p_ + 768); } while (0)
#define HG_FLUSH(ci, b) do { const int t0_ = d ? (len - 16 - (ci) * 16) : (ci) * 16; \
    const float* y_ = yst + (b) * 1024 + ptok * 64 + (tid & 31) * 2; *(unsigned*)(outp + (size_t)(start + t0_ + ptok) * ldo + coff + h * 64 + (tid & 31) * 2) = pk2(y_[0], y_[1]); } while (0)
  HG_ISSUE(0, rawA); HG_ISSUE(1, rawB); HG_ISSUE(2, rawC); HG_ISSUE(3, rawD);
  auto body = [&](unsigned (&raw)[3], const int ci, const int b) __attribute__((always_inline)) {
    {
      const float q0 = bflo(raw[0]), q1 = bfhi(raw[0]), z0 = bflo(raw[1]), z1 = bfhi(raw[1]);
      const float s0 = sigmoidf_(z0), s1 = sigmoidf_(z1);
      const float f0 = fmaxf(lb0 + (1.f - lb0) * s0, 1e-30f), f1 = fmaxf(lb1 + (1.f - lb1) * s1, 1e-30f);
      const float k0 = (1.f - lb0) / (1.f + __expf(z0)), k1 = (1.f - lb1) / (1.f + __expf(z1));
      float* B = buf + b * 4096 + ptok * 64 + pc;
      *(float2*)(B) = make_float2(f0, f1);
      *(float2*)(B + 1024) = make_float2(k0, k1);
      *(float2*)(B + 2048) = make_float2(siluf_(q0), siluf_(q1));
      *(float2*)(B + 3072) = make_float2(bflo(raw[2]), bfhi(raw[2]));
    }
    asm volatile("s_waitcnt lgkmcnt(0)" ::: "memory"); __builtin_amdgcn_s_barrier(); asm volatile("" ::: "memory");
    if (ci > 0) HG_FLUSH(ci - 1, b ^ 1);
    if (ci + 4 < nch) HG_ISSUE(ci + 4, raw);
    {
      struct Ops { f32x4 f0, f1, k0, k1, q0, q1; float vv; };
#define HG_LD(o, st_) do { const int tt_ = d ? 15 - (st_) : (st_); const float* B_ = buf + b * 4096 + tt_ * 64 + kq * 8; \
        o.f0 = *(const f32x4*)(B_); o.f1 = *(const f32x4*)(B_ + 4); o.k0 = *(const f32x4*)(B_ + 1024); o.k1 = *(const f32x4*)(B_ + 1028); \
        o.q0 = *(const f32x4*)(B_ + 2048); o.q1 = *(const f32x4*)(B_ + 2052); o.vv = buf[b * 4096 + 3072 + tt_ * 64 + col]; } while (0)
      Ops ring[3];
      HG_LD(ring[0], 0); HG_LD(ring[1], 1);
      float ykeep = 0.f;
#pragma unroll
      for (int st = 0; st < 16; ++st) {
        if (st < 14) HG_LD(ring[(st + 2) % 3], st + 2);
        __builtin_amdgcn_sched_barrier(0);
        const Ops& cur = ring[st % 3];
        const f32x2 vv2 = {cur.vv, cur.vv};
        S2[0] = lo2(cur.f0) * S2[0] + lo2(cur.k0) * vv2; S2[1] = hi2(cur.f0) * S2[1] + hi2(cur.k0) * vv2;
        S2[2] = lo2(cur.f1) * S2[2] + lo2(cur.k1) * vv2; S2[3] = hi2(cur.f1) * S2[3] + hi2(cur.k1) * vv2;
        f32x2 oa = S2[0] * lo2(cur.q0); oa += S2[1] * hi2(cur.q0); oa += S2[2] * lo2(cur.q1); oa += S2[3] * hi2(cur.q1);
        const float yv = red8(oa[0] + oa[1]);
        ykeep = (kq == (st & 7)) ? yv : ykeep;
        if ((st & 7) == 7) { const int tk = (st & 8) + kq; yst[b * 1024 + (d ? 15 - tk : tk) * 64 + coll] = ykeep; }
      }
#undef HG_LD
    }
  };
  for (int ci2 = 0; ci2 < nch; ci2 += 4) { body(rawA, ci2, 0); body(rawB, ci2 + 1, 1); body(rawC, ci2 + 2, 0); body(rawD, ci2 + 3, 1); }
  __syncthreads();
  HG_FLUSH(nch - 1, (nch - 1) & 1);
  if (s < 32) {
    float* op = P.o_hgrn + ((((size_t)s * 2 + l) * 2 + d) * 4 + h) * 4096;
#pragma unroll
    for (int i = 0; i < 4; ++i) { op[(kq * 8 + 2 * i) * 64 + col] = S2[i][0]; op[(kq * 8 + 2 * i + 1) * 64 + col] = S2[i][1]; }
  }
  __syncthreads();
#undef HG_ISSUE
#undef HG_FLUSH
}

DI void s5_block(const Params& P, int l, int s, int d, int goct, unsigned char* lds) {
  int tid = threadIdx.x; asm volatile("" : "+v"(tid)); const int wid = tid >> 6, lane = tid & 63, fr = lane & 15, fq = lane >> 4;
  const int g = goct * 8 + wid;
  int start, len; seq_info(s, start, len);
  float* bu = (float*)(lds + wid * 12800);
  u16* sb = (u16*)(lds + wid * 12800 + 8448);
  float abr, abi, zr, zi;
  {
    const float dt = expf(P.s5_log_dt[(l * 2 + d) * 16 + g]);
    const float lre = P.s5_a_re[(size_t)((l * 2 + d) * 16 + g) * 64 + lane], lim = P.s5_a_im[(size_t)((l * 2 + d) * 16 + g) * 64 + lane];
    const float x = lre * dt, th = lim * dt; const float mag = expf(x); float sn, cs; sincosf(th, &sn, &cs);
    abr = mag * cs; abi = mag * sn;
    const float shalf = sinf(0.5f * th); const float abm1 = expm1f(x) * cs - 2.0f * shalf * shalf;
    const float den = lre * lre + lim * lim;
    zr = (abm1 * lre + abi * lim) / den; zi = (abi * lre - abm1 * lim) / den;
  }
  bf16x8 bbf[8], ccf[4];
#pragma unroll
  for (int nt = 0; nt < 8; ++nt) {
    const int nsrc = nt * 8 + (fr >> 1), ri = fr & 1;
    const float z_r = __shfl(zr, nsrc), z_i = __shfl(zi, nsrc);
    const float* br = P.s5_b_re + ((size_t)(l * 16 + g) * 64 + nsrc) * 16; const float* bi = P.s5_b_im + ((size_t)(l * 16 + g) * 64 + nsrc) * 16;
#pragma unroll
    for (int j = 0; j < 8; ++j) {
      float v = 0.f;
      if (fq < 2) { const float b_r = br[fq * 8 + j], b_i = bi[fq * 8 + j]; v = ri ? (z_r * b_i + z_i * b_r) : (z_r * b_r - z_i * b_i); }
      bbf[nt][j] = (short)f2bf(v);
    }
  }
#pragma unroll
  for (int ks = 0; ks < 4; ++ks)
#pragma unroll
    for (int j = 0; j < 8; ++j) {
      const int n = ks * 16 + fq * 4 + (j >> 1);
      const size_t ix = ((size_t)(l * 16 + g) * 16 + fr) * 64 + n;
      ccf[ks][j] = (short)f2bf((j & 1) ? -P.s5_c_im[ix] : P.s5_c_re[ix]);
    }
  float sre = 0.f, sim = 0.f;
  if (s >= 32) { const float* sp = P.st_s5 + (((((size_t)(s - 32) * 2 + l) * 2 + d) * 16 + g) * 64 + lane) * 2; sre = sp[0]; sim = sp[1]; }
  const u16* pB = P.R1 + (size_t)MTOK * 1024;
  u16* outp = d ? (P.YB + (size_t)MTOK * 256) : P.H; const int ldo = d ? 256 : 1024; const int coff = d ? 0 : 256;
  const int nch = len >> 4;
  const u32x4 zero4 = {0u, 0u, 0u, 0u};
#define S5_LOADU(ci) ((fq < 2) ? *(const u32x4*)(pB + (size_t)(start + (d ? (len - 16 - (ci) * 16) : (ci) * 16) + fr) * 256 + g * 16 + fq * 8) : zero4)
  u32x4 u0 = S5_LOADU(0), u1 = zero4, u2 = zero4;
  if (nch > 1) u1 = S5_LOADU(1);
  if (nch > 2) u2 = S5_LOADU(2);
  for (int ci = 0; ci < nch; ++ci) {
    const u32x4 uc = u0; u0 = u1; u1 = u2; if (ci + 3 < nch) u2 = S5_LOADU(ci + 3);
    const bf16x8 ua = __builtin_bit_cast(bf16x8, uc);
#pragma unroll
    for (int nt = 0; nt < 8; ++nt) {
      f32x4 acc = {0.f, 0.f, 0.f, 0.f};
      acc = __builtin_amdgcn_mfma_f32_16x16x32_bf16(ua, bbf[nt], acc, 0, 0, 0);
#pragma unroll
      for (int j = 0; j < 4; ++j) bu[(fq * 4 + j) * 132 + nt * 16 + fr] = acc[j];
    }
    asm volatile("s_waitcnt lgkmcnt(0)" ::: "memory");
    float2 bq[16];
#pragma unroll
    for (int st = 0; st < 16; ++st) bq[st] = *(const float2*)(bu + (d ? 15 - st : st) * 132 + 2 * lane);
#pragma unroll
    for (int st = 0; st < 16; ++st) {
      const int tt = d ? 15 - st : st;
      const float2 b2 = bq[st];
      const float nr = abr * sre - abi * sim + b2.x, ni = abr * sim + abi * sre + b2.y;
      sre = nr; sim = ni;
      *(unsigned*)(sb + tt * 136 + 2 * lane) = pk2(sre, sim);
    }
    asm volatile("s_waitcnt lgkmcnt(0)" ::: "memory");
    f32x4 acc = {0.f, 0.f, 0.f, 0.f};
#pragma unroll
    for (int ks = 0; ks < 4; ++ks) {
      const bf16x8 a = *(const bf16x8*)(sb + fr * 136 + ks * 32 + fq * 8);
      acc = __builtin_amdgcn_mfma_f32_16x16x32_bf16(a, ccf[ks], acc, 0, 0, 0);
    }
    const int t0 = d ? (len - 16 - ci * 16) : ci * 16;
#pragma unroll
    for (int j = 0; j < 4; ++j) outp[(size_t)(start + t0 + fq * 4 + j) * ldo + coff + g * 16 + fr] = f2bf(acc[j]);
    asm volatile("s_waitcnt lgkmcnt(0)" ::: "memory");
  }
  __syncthreads();
  if (s < 32) { float* op = P.o_s5 + (((((size_t)s * 2 + l) * 2 + d) * 16 + g) * 64 + lane) * 2; op[0] = sre; op[1] = sim; }
#undef S5_LOADU
}

DI void attn_job(const Params& P, int l, int type, int b, int rq, int hp, unsigned char* lds) {
  int tid = threadIdx.x; asm volatile("" : "+v"(tid)); const int wid = tid >> 6, lane = tid & 63, fr = lane & 15, fq = lane >> 4;
  const int hh = wid >> 2, qg = wid & 3, head = hp * 2 + hh;
  const u16* pD = P.R1 + (size_t)MTOK * 2560;
  unsigned char* ldsK = lds;
  u16* ldsV = (u16*)(lds + 32768);
  float* rpbL = (float*)(lds + 32768 + 36864);
  const int mq0 = type == 0 ? (NCTX + b * 4096 + rq * 64) : (b * 256 + rq * 64);
  const int mq = mq0 + qg * 16 + fr;
  bf16x8 qf[2];
  qf[0] = *(const bf16x8*)(pD + (size_t)mq * 768 + head * 64 + fq * 8);
  qf[1] = *(const bf16x8*)(pD + (size_t)mq * 768 + head * 64 + 32 + fq * 8);
  const int nchunks = type == 0 ? 12 : 4, nloc = type == 0 ? 8 : 4;
  const int rs = type == 0 ? min(max(rq - 4, 0), 56) : 0;
  const int mk0 = type == 0 ? (NCTX + b * 4096 + rs * 64) : (b * 256);
  if (type == 0) for (int i = tid; i < 930; i += NTHR) rpbL[i] = P.na_rpb[(size_t)(l * 4 + hp * 2) * 465 + i];
  const int sh = tid >> 8, skey = (tid >> 2) & 63, sdq = tid & 3, shead = hp * 2 + sh;
  u32x4 krA[2], vrA[2], krB[2], vrB[2];
#define AT_ISSUE(ci, kr, vr) do { const u16* kp_; const u16* vp_; \
    if ((ci) < nloc) { kp_ = pD + (size_t)(mk0 + (ci) * 64 + skey) * 768 + 256 + shead * 64 + sdq * 16; vp_ = kp_ + 256; } \
    else { const size_t o_ = ((size_t)(b * 256 + ((ci) - nloc) * 64 + skey)) * 256 + shead * 64 + sdq * 16; kp_ = P.KC + o_; vp_ = P.VC + o_; } \
    kr[0] = *(const u32x4*)kp_; kr[1] = *(const u32x4*)(kp_ + 8); vr[0] = *(const u32x4*)vp_; vr[1] = *(const u32x4*)(vp_ + 8); } while (0)
  float mrun = -1e30f, lrun = 0.f;
  f32x4 oacc[4];
#pragma unroll
  for (int i = 0; i < 4; ++i) oacc[i] = (f32x4){0.f, 0.f, 0.f, 0.f};
  const int w = qg * 16 + fr; const int cs = min(max(w - 8, 0), 48);
  AT_ISSUE(0, krA, vrA); AT_ISSUE(1, krB, vrB);
  auto chunk = [&](u32x4 (&kr)[2], u32x4 (&vr)[2], const int ci, const int buf) __attribute__((always_inline)) {
    {
      const u32x4 k0 = kr[0], k1 = kr[1], v0 = vr[0], v1 = vr[1];
      unsigned char* kb = ldsK + (buf * 2 + sh) * 8192 + skey * 128; const int sw = (skey >> 1) & 7;
      *(u32x4*)(kb + (((2 * sdq) ^ sw) << 4)) = k0; *(u32x4*)(kb + (((2 * sdq + 1) ^ sw) << 4)) = k1;
      u16* vt = ldsV + (buf * 2 + sh) * (64 * 72) + (sdq * 16) * 72 + skey;
#pragma unroll
      for (int i = 0; i < 4; ++i) { vt[(2 * i) * 72] = (u16)(v0[i] & 0xffffu); vt[(2 * i + 1) * 72] = (u16)(v0[i] >> 16);
                                    vt[(8 + 2 * i) * 72] = (u16)(v1[i] & 0xffffu); vt[(8 + 2 * i + 1) * 72] = (u16)(v1[i] >> 16); }
    }
    __syncthreads();
    if (ci + 2 < nchunks) AT_ISSUE(ci + 2, kr, vr);
    const unsigned char* kb = ldsK + (buf * 2 + hh) * 8192;
    const u16* vb = ldsV + (buf * 2 + hh) * (64 * 72);
    f32x4 sacc[4];
#pragma unroll
    for (int kt = 0; kt < 4; ++kt) {
      sacc[kt] = (f32x4){0.f, 0.f, 0.f, 0.f};
#pragma unroll
      for (int ks = 0; ks < 2; ++ks) {
        const bf16x8 a = *(const bf16x8*)(kb + (kt * 16 + fr) * 128 + (((ks * 4 + fq) ^ ((fr >> 1) & 7)) << 4));
        sacc[kt] = __builtin_amdgcn_mfma_f32_16x16x32_bf16(a, qf[ks], sacc[kt], 0, 0, 0);
      }
    }
    float mx = -1e30f;
    if (type == 0 && ci < nloc) {
      const int dr = rs + ci - rq + 7;
      const float* bp = rpbL + hh * 465 + dr * 31;
#pragma unroll
      for (int kt = 0; kt < 4; ++kt)
#pragma unroll
        for (int j = 0; j < 4; ++j) {
          const int kc = kt * 16 + fq * 4 + j; const bool valid = (kc >= cs) && (kc < cs + 16);
          const int dc = min(max(kc - w + 15, 0), 30);
          const float sv = valid ? (sacc[kt][j] * 0.125f + bp[dc]) : -1e30f;
          sacc[kt][j] = sv; mx = fmaxf(mx, sv);
        }
    } else {
#pragma unroll
      for (int kt = 0; kt < 4; ++kt)
#pragma unroll
        for (int j = 0; j < 4; ++j) { const float sv = sacc[kt][j] * 0.125f; sacc[kt][j] = sv; mx = fmaxf(mx, sv); }
    }
    mx = fmaxf(mx, __shfl_xor(mx, 16)); mx = fmaxf(mx, __shfl_xor(mx, 32));
    const float mnew = fmaxf(mrun, mx); const float alpha = __expf(mrun - mnew);
    float ps = 0.f;
#pragma unroll
    for (int kt = 0; kt < 4; ++kt)
#pragma unroll
      for (int j = 0; j < 4; ++j) { const float pv = __expf(sacc[kt][j] - mnew); sacc[kt][j] = pv; ps += pv; }
    ps += __shfl_xor(ps, 16); ps += __shfl_xor(ps, 32);
    lrun = lrun * alpha + ps; mrun = mnew;
    bf16x8 pb[2];
#pragma unroll
    for (int k2 = 0; k2 < 2; ++k2) {
      u32x4 t; t.x = pk2(sacc[2 * k2][0], sacc[2 * k2][1]); t.y = pk2(sacc[2 * k2][2], sacc[2 * k2][3]);
      t.z = pk2(sacc[2 * k2 + 1][0], sacc[2 * k2 + 1][1]); t.w = pk2(sacc[2 * k2 + 1][2], sacc[2 * k2 + 1][3]);
      pb[k2] = __builtin_bit_cast(bf16x8, t);
    }
#pragma unroll
    for (int mt = 0; mt < 4; ++mt) {
      oacc[mt] = oacc[mt] * alpha;
#pragma unroll
      for (int k2 = 0; k2 < 2; ++k2) {
        const u16* vp = vb + (mt * 16 + fr) * 72 + (2 * k2) * 16 + fq * 4;
        const u32x2 lo = *(const u32x2*)vp, hi = *(const u32x2*)(vp + 16);
        const u32x4 av = {lo.x, lo.y, hi.x, hi.y};
        oacc[mt] = __builtin_amdgcn_mfma_f32_16x16x32_bf16(__builtin_bit_cast(bf16x8, av), pb[k2], oacc[mt], 0, 0, 0);
      }
    }
  };
  for (int ci2 = 0; ci2 < nchunks; ci2 += 2) { chunk(krA, vrA, ci2, 0); chunk(krB, vrB, ci2 + 1, 1); }
  const float il = 1.0f / lrun;
#pragma unroll
  for (int mt = 0; mt < 4; ++mt) {
    u32x2 o; o.x = pk2(oacc[mt][0] * il, oacc[mt][1] * il); o.y = pk2(oacc[mt][2] * il, oacc[mt][3] * il);
    *(u32x2*)(P.H + (size_t)mq * 1024 + 768 + head * 64 + mt * 16 + fq * 4) = o;
  }
  __syncthreads();
#undef AT_ISSUE
}

#define NMIXJOBS 2400
#ifndef PROBE_JOBLO
#define PROBE_JOBLO 0
#define PROBE_JOBHI 0
#endif
DI void phase_mixer(const Params& P, int l, unsigned char* lds, volatile int* sjob, unsigned long long& pacc) {
  for (;;) {
    __syncthreads();
    if (threadIdx.x == 0) *sjob = (int)atomicAdd(P.qctr + l, 1u);
    __syncthreads();
    const int job = *sjob;
    if (job >= NMIXJOBS) break;
    int kind, a0, a1, a2, a3 = 0, a4 = 0;
    if (job < 32) { const int u = job; kind = 2; a0 = 32 + (u >> 2); a1 = (u >> 1) & 1; a2 = u & 1; }
    else if (job < 160) { const int u = job - 32; kind = 0; a0 = 32 + (u >> 4); a1 = (u >> 2) & 3; a2 = (u >> 1) & 1; a4 = u & 1; }
    else if (job < 224) { const int u = job - 160; kind = 1; a0 = 32 + (u >> 3); a1 = (u >> 1) & 3; a2 = u & 1; }
    else if (job < 736) { const int u = job - 224; kind = 0; a0 = u >> 4; a1 = (u >> 2) & 3; a2 = (u >> 1) & 1; a4 = u & 1; }
    else if (job < 992) { const int u = job - 736; kind = 1; a0 = u >> 3; a1 = (u >> 1) & 3; a2 = u & 1; }
    else if (job < 1120) { const int u = job - 992; kind = 2; a0 = u >> 2; a1 = (u >> 1) & 1; a2 = u & 1; }
    else if (job < 2144) { const int u = job - 1120; kind = 3; a0 = u >> 7; a1 = (u >> 1) & 63; a2 = u & 1; a3 = 0; }
    else { const int u = job - 2144; kind = 3; a0 = u >> 3; a1 = (u >> 1) & 3; a2 = u & 1; a3 = 1; }
    const unsigned long long tj0 = (PROBE_JOBHI > 0) ? __builtin_amdgcn_s_memrealtime() : 0ull;
    if (kind == 0) rwkv_unit(P, l, a0, a1, a2, a4, lds);
    else if (kind == 1) hgrn_unit(P, l, a0, a1, a2, a4, lds);
    else if (kind == 2) s5_block(P, l, a0, a1, a2, lds);
    else attn_job(P, l, a3, a0, a1, a2, lds);
    if (PROBE_JOBHI > 0 && job >= PROBE_JOBLO && job < PROBE_JOBHI) pacc += __builtin_amdgcn_s_memrealtime() - tj0;
  }
}

DI void phase_final(const Params& P, int l, unsigned char* lds) {
  u16* sgA = (u16*)lds;
  u16* glA = sgA + 32 * 136;
  float* oaL = (float*)(glA + 32 * 264);
  const int tid = ltid(); const int wid = tid >> 6, lane = tid & 63, fr = lane & 15, fq = lane >> 4;
  const int cp = tid & 127, tg = tid >> 7, c0 = cp * 2;
  const u16* pA = P.R1; const u16* pB = P.R1 + (size_t)MTOK * 1024; const u16* pC = P.R1 + (size_t)MTOK * 1280;
  float mup[3][2], mun[3][2];
#pragma unroll
  for (int k = 0; k < 3; ++k)
#pragma unroll
    for (int e = 0; e < 2; ++e) { mup[k][e] = P.rw_mu[(size_t)(l * 2 + 0) * 1024 + k * 256 + c0 + e]; mun[k][e] = P.rw_mu[(size_t)(l * 2 + 1) * 1024 + k * 256 + c0 + e]; }
  const float2 k_a = *(const float2*)(P.rw_k_a + l * 256 + c0), r_k = *(const float2*)(P.rw_r_k + l * 256 + c0);
  const float2 lnxg = *(const float2*)(P.rw_lnx_g + l * 256 + c0), lnxb = *(const float2*)(P.rw_lnx_b + l * 256 + c0);
  const float2 s5d = *(const float2*)(P.s5_d + l * 256 + c0), hgg = *(const float2*)(P.hg_norm_g + l * 256 + c0);
  float glub[2];
#pragma unroll
  for (int nt = 0; nt < 2; ++nt) glub[nt] = P.s5_glu_b[l * 256 + wid * 32 + nt * 16 + fr];
  for (int job = blockIdx.x; job < MTOK / 32; job += gridDim.x) {
    const int m0 = job * 32;
    int start, len; { const int s = m0 < NCTX ? (m0 >> 8) : 32 + ((m0 - NCTX) >> 12); seq_info(s, start, len); }
    {
      const int t = tid >> 4, cg = tid & 15; const int m = m0 + t, tt = m - start; const int col = 896 + cg * 8;
      const u16* p0 = pA + (size_t)m * 1024 + col;
      u32x4 cc = *(const u32x4*)p0, pv = {0, 0, 0, 0}, nx = {0, 0, 0, 0};
      if (tt > 0) pv = *(const u32x4*)(p0 - 1024);
      if (tt < len - 1) nx = *(const u32x4*)(p0 + 1024);
      float sh[8];
#pragma unroll
      for (int i = 0; i < 8; ++i) {
        const unsigned cw = cc[i >> 1], pw = pv[i >> 1], nw = nx[i >> 1];
        const float x = (i & 1) ? bfhi(cw) : bflo(cw), xp = (i & 1) ? bfhi(pw) : bflo(pw), xn = (i & 1) ? bfhi(nw) : bflo(nw);
        sh[i] = sigmoidf_(x + P.rw_mu[(size_t)(l * 2 + 0) * 1024 + col + i] * (xp - x) + P.rw_mu[(size_t)(l * 2 + 1) * 1024 + col + i] * (xn - x));
      }
      u32x4 w; w.x = pk2(sh[0], sh[1]); w.y = pk2(sh[2], sh[3]); w.z = pk2(sh[4], sh[5]); w.w = pk2(sh[6], sh[7]);
      *(u32x4*)(sgA + t * 136 + cg * 8) = w;
    }
#pragma unroll 2
    for (int ti = 0; ti < 8; ++ti) {
      const int t = tg * 8 + ti; const int m = m0 + t, tt = m - start;
      const unsigned yf = *(const unsigned*)(P.H + (size_t)m * 1024 + c0), yb = *(const unsigned*)(P.YB + (size_t)m * 256 + c0);
      const float y0 = bflo(yf) + bflo(yb), y1 = bfhi(yf) + bfhi(yb);
      const float mean = hsum32(y0 + y1) * (1.0f / 64.0f); const float d0 = y0 - mean, d1 = y1 - mean;
      const float var = hsum32(d0 * d0 + d1 * d1) * (1.0f / 64.0f); const float rs = 1.0f / sqrtf(var + 64e-5f);
      float sh[3][2];
#pragma unroll
      for (int k = 0; k < 3; ++k) {
        const u16* p0 = pA + (size_t)m * 1024 + k * 256 + c0;
        const unsigned cw = *(const unsigned*)p0, pw = (tt > 0) ? *(const unsigned*)(p0 - 1024) : 0u, nw = (tt < len - 1) ? *(const unsigned*)(p0 + 1024) : 0u;
        const float x0 = bflo(cw), x1 = bfhi(cw);
        sh[k][0] = x0 + mup[k][0] * (bflo(pw) - x0) + mun[k][0] * (bflo(nw) - x0);
        sh[k][1] = x1 + mup[k][1] * (bfhi(pw) - x1) + mun[k][1] * (bfhi(nw) - x1);
      }
      const unsigned aw = *(const unsigned*)(P.PA + (size_t)m * 256 + c0);
      const float ke0 = sh[1][0] * (1.f + (bflo(aw) - 1.f) * k_a.x), ke1 = sh[1][1] * (1.f + (bfhi(aw) - 1.f) * k_a.y);
      const float bsum = hsum32(sh[0][0] * ke0 * r_k.x + sh[0][1] * ke1 * r_k.y);
      *(float2*)(oaL + t * 258 + c0) = make_float2(d0 * rs * lnxg.x + lnxb.x + bsum * sh[2][0], d1 * rs * lnxg.y + lnxb.y + bsum * sh[2][1]);
      const unsigned sf = *(const unsigned*)(P.H + (size_t)m * 1024 + 256 + c0), sb2 = *(const unsigned*)(P.YB + (size_t)(MTOK + m) * 256 + c0), uw = *(const unsigned*)(pB + (size_t)m * 256 + c0);
      const float ys0 = bflo(sf) + bflo(sb2) + s5d.x * bflo(uw), ys1 = bfhi(sf) + bfhi(sb2) + s5d.y * bfhi(uw);
      const float gl0 = 0.5f * ys0 * (1.0f + tanhf(0.7978845608f * (ys0 + 0.044715f * ys0 * ys0 * ys0)));
      const float gl1 = 0.5f * ys1 * (1.0f + tanhf(0.7978845608f * (ys1 + 0.044715f * ys1 * ys1 * ys1)));
      *(unsigned*)(glA + t * 264 + c0) = pk2(gl0, gl1);
      const unsigned of = *(const unsigned*)(P.H + (size_t)m * 1024 + 512 + c0), ob = *(const unsigned*)(P.YB + (size_t)(2 * MTOK + m) * 256 + c0), gw = *(const unsigned*)(pC + (size_t)m * 1280 + 1024 + c0);
      const float o0 = bflo(of) + bflo(ob), o1 = bfhi(of) + bfhi(ob);
      const float ms = hsum32(o0 * o0 + o1 * o1) * (1.0f / 64.0f); const float ir = 1.0f / sqrtf(ms + 1e-5f);
      *(unsigned*)(P.H + (size_t)m * 1024 + 512 + c0) = pk2(o0 * ir * hgg.x * siluf_(bflo(gw)), o1 * ir * hgg.y * siluf_(bfhi(gw)));
    }
    __syncthreads();
#pragma unroll
    for (int nt = 0; nt < 2; ++nt) {
      const int n = wid * 32 + nt * 16 + fr;
      f32x4 cg2[2], cl[2];
#pragma unroll
      for (int mt = 0; mt < 2; ++mt) { cg2[mt] = (f32x4){0.f, 0.f, 0.f, 0.f}; cl[mt] = cg2[mt]; }
#pragma unroll
      for (int ks = 0; ks < 8; ++ks) {
        const bf16x8 bgl = *(const bf16x8*)(P.WGLU + (size_t)n * 256 + ks * 32 + fq * 8);
#pragma unroll
        for (int mt = 0; mt < 2; ++mt) cl[mt] = __builtin_amdgcn_mfma_f32_16x16x32_bf16(*(const bf16x8*)(glA + (mt * 16 + fr) * 264 + ks * 32 + fq * 8), bgl, cl[mt], 0, 0, 0);
        if (ks < 4) {
          const bf16x8 bgu = *(const bf16x8*)(P.WGUP + (size_t)n * 128 + ks * 32 + fq * 8);
#pragma unroll
          for (int mt = 0; mt < 2; ++mt) cg2[mt] = __builtin_amdgcn_mfma_f32_16x16x32_bf16(*(const bf16x8*)(sgA + (mt * 16 + fr) * 136 + ks * 32 + fq * 8), bgu, cg2[mt], 0, 0, 0);
        }
      }
#pragma unroll
      for (int mt = 0; mt < 2; ++mt)
#pragma unroll
        for (int j = 0; j < 4; ++j) {
          const int t = mt * 16 + fq * 4 + j; const size_t o = (size_t)(m0 + t) * 1024 + n;
          P.H[o] = f2bf(oaL[t * 258 + n] * cg2[mt][j]);
          P.H[o + 256] = f2bf(bf2f(glA[t * 264 + n]) * sigmoidf_(cl[mt][j] + glub[nt]));
        }
    }
    __syncthreads();
  }
}

#define NPHASES 26
DI void run_phase(const Params& P, int ph, unsigned char* lds, volatile int* sjob, unsigned long long& pacc) {
  PG8_LAS unsigned char* ldsa = (PG8_LAS unsigned char*)lds;
  if (ph == 0) { phase_p0(P, lds); return; }
  if (ph == 25) { phase_lnmod(P, P.ln_g + (size_t)(1 * 3 + 2) * 1024, P.ln_b + (size_t)(1 * 3 + 2) * 1024, nullptr, 0, 0, 1); return; }
  const int l = (ph - 1) / 12, sp = (ph - 1) % 12;
  const float* modl = P.mod + (size_t)l * 9 * 9216;
  const float* lng = P.ln_g + (size_t)l * 3 * 1024; const float* lnb = P.ln_b + (size_t)l * 3 * 1024;
  switch (sp) {
    case 0:
      if (l == 0) phase_lnmod(P, nullptr, nullptr, modl, 0, 1, 0);
      else {
        convert_all(P, 1, (float*)lds);
        phase_lnmod(P, P.ln_g + (size_t)(0 * 3 + 2) * 1024, P.ln_b + (size_t)(0 * 3 + 2) * 1024, modl, 0, 0, 0);
      }
      break;
    case 1: { EpiSwiglu E; E.O = P.R1; run_gemm(ldsa, P.H, P.WA0, MTOK, 5632, 1024, E); } break;
    case 2: { EpiResid E{P, l * 9 * 9216 + 2 * 1024, 0.5f, (l == 0) ? 0 : 2, 2 * 1024}; run_gemm(ldsa, P.R1, P.WB0, MTOK, 1024, DFF, E); } break;
    case 3: phase_lnmod(P, lng, lnb, modl, 3, 0, 0); break;
    case 4: { EpiP E; E.R1 = P.R1; E.nak = P.o_nak; E.nav = P.o_nav; E.l = l; run_gemm(ldsa, P.H, P.WC, MTOK, 3328, 1024, E); } break;
    case 5: phase_prep(P, l, lds); break;
    case 6: phase_mixer(P, l, lds, sjob, pacc); break;
    case 7: phase_final(P, l, lds); break;
    case 8: { EpiResid E{P, l * 9 * 9216 + 5 * 1024, 1.0f, 2, l * 3 * 1024}; run_gemm(ldsa, P.H, P.WD, MTOK, 1024, 1024, E); } break;
    case 9: phase_lnmod(P, lng + 1024, lnb + 1024, modl, 6, 0, 0); break;
    case 10: { EpiSwiglu E; E.O = P.R1; run_gemm(ldsa, P.H, P.WA1, MTOK, 5632, 1024, E); } break;
    case 11: { EpiResid E{P, l * 9 * 9216 + 8 * 1024, 0.5f, 2, l * 3 * 1024 + 1024}; run_gemm(ldsa, P.R1, P.WB1, MTOK, 1024, DFF, E); } break;
  }
}

extern __shared__ __attribute__((aligned(16))) unsigned char dyn_lds[];

#ifndef PROBE_MASK
#define PROBE_MASK 0
#endif
__global__ __launch_bounds__(NTHR, 2) void k_mega(Params P) {
  __shared__ uint4 xb_words;
  __shared__ int sjob_s[4];
  cg::grid_group grid = cg::this_grid();
  if (threadIdx.x == 0) xb_words = make_uint4(0u, 0u, 0u, 0u);
  __syncthreads();
  XcdBarrier xb = xcd_barrier_post(P.bar, (volatile LAS unsigned*)&xb_words);
  if (P.qctr == nullptr) grid.sync();
  unsigned long long tsel = 0ull;
#pragma unroll 1
  for (int ph = 0; ph < NPHASES; ++ph) {
#if PROBE_MASK
    const unsigned long long t0 = __builtin_amdgcn_s_memrealtime();
#endif
    run_phase(P, ph, dyn_lds, sjob_s, tsel);
    if (ph + 1 < NPHASES) xcd_barrier(xb);
#if PROBE_MASK
    if ((PROBE_MASK >> ph) & 1) tsel += __builtin_amdgcn_s_memrealtime() - t0;
#endif
  }
#if PROBE_MASK || PROBE_JOBHI
  { const unsigned long long t1 = __builtin_amdgcn_s_memrealtime(); while (__builtin_amdgcn_s_memrealtime() - t1 < tsel) __builtin_amdgcn_s_sleep(8); }
#endif
}
#if !MEGA
__global__ __launch_bounds__(NTHR, 2) void k_one(Params P, int ph) {
  __shared__ int sjob_s[4];
  unsigned long long dummy = 0ull;
  run_phase(P, ph, dyn_lds, sjob_s, dummy);
}

#endif
#define LDS_BYTES 131072

extern "C" void kernel_launch(void* const* d_in, const int* in_sizes, int n_in, void* d_out, int out_size, void* d_ws, size_t ws_size, hipStream_t stream) {
  Params P{};
  const float* const* in = (const float* const*)d_in;
  P.x_prompt = in[0]; P.x_sample = in[1]; P.cache_k = in[2]; P.cache_v = in[3]; P.st_rwkv = in[4]; P.st_s5 = in[5]; P.st_hgrn = in[6]; P.c = in[7]; P.c_ctx = in[8];
  P.w_mod = in[9]; P.b_mod = in[10]; P.ln_g = in[11]; P.ln_b = in[12]; P.ffn_w_in = in[13]; P.ffn_w_out = in[14]; P.w_in = in[15]; P.w_out = in[16];
  P.rw_mu = in[17]; P.rw_w0 = in[18]; P.rw_w_up = in[19]; P.rw_a0 = in[20]; P.rw_a_up = in[21]; P.rw_g_up = in[22]; P.rw_k_k = in[23]; P.rw_k_a = in[24]; P.rw_r_k = in[25];
  P.rw_lnx_g = in[26]; P.rw_lnx_b = in[27];
  P.s5_a_re = in[28]; P.s5_a_im = in[29]; P.s5_log_dt = in[30]; P.s5_b_re = in[31]; P.s5_b_im = in[32]; P.s5_c_re = in[33]; P.s5_c_im = in[34]; P.s5_d = in[35];
  P.s5_glu_w = in[36]; P.s5_glu_b = in[37]; P.hg_lb = in[38]; P.hg_norm_g = in[39]; P.na_rpb = in[40];
  float* out = (float*)d_out;
  P.X = out; size_t o = (size_t)MTOK * 1024;
  P.o_nak = out + o; o += (size_t)32 * 2 * 256 * 256;
  P.o_nav = out + o; o += (size_t)32 * 2 * 256 * 256;
  P.o_rwkv = out + o; o += (size_t)32 * 2 * 2 * 4 * 4096;
  P.o_s5 = out + o; o += (size_t)32 * 2 * 2 * 16 * 128;
  P.o_hgrn = out + o;
  unsigned char* w = (unsigned char*)d_ws; size_t off = 0;
  auto take = [&](size_t bytes) { unsigned char* p = w + off; off += (bytes + 255) & ~(size_t)255; return p; };
  P.qctr = (unsigned*)take(256);
  P.bar = (unsigned*)take((size_t)XCD_BAR_WORDS * 4);
  P.mod = (float*)take((size_t)2 * 9 * 9216 * 4);
  P.ST = (float*)take((size_t)MTOK * 2 * 4);
  P.WA0 = (u16*)take((size_t)5632 * 1024 * 2); P.WA1 = (u16*)take((size_t)5632 * 1024 * 2);
  P.WB0 = (u16*)take((size_t)1024 * DFF * 2); P.WB1 = (u16*)take((size_t)1024 * DFF * 2);
  P.WC = (u16*)take((size_t)3328 * 1024 * 2); P.WD = (u16*)take((size_t)1024 * 1024 * 2);
  P.WGLU = (u16*)take(256 * 256 * 2); P.WGUP = (u16*)take(256 * 128 * 2); P.WAUP = (u16*)take(256 * 64 * 2); P.WWUP0 = (u16*)take(256 * 64 * 2); P.WWUP1 = (u16*)take(256 * 64 * 2);
  P.R1 = (u16*)take((size_t)MTOK * 3328 * 2);
  P.H = (u16*)take((size_t)MTOK * 1024 * 2);
  P.PA = (u16*)take((size_t)MTOK * 256 * 2); P.PE0 = (u16*)take((size_t)MTOK * 256 * 2); P.PE1 = (u16*)take((size_t)MTOK * 256 * 2);
  P.YB = (u16*)take((size_t)MTOK * 768 * 2);
  P.KC = (u16*)take((size_t)8 * 256 * 256 * 2); P.VC = (u16*)take((size_t)8 * 256 * 256 * 2);
  if (off > ws_size) fprintf(stderr, "workspace too small: need %zu have %zu\n", off, ws_size);
  static int configured = 0;
  if (!configured) {
    (void)hipFuncSetAttribute((const void*)k_mega, hipFuncAttributeMaxDynamicSharedMemorySize, LDS_BYTES);
#if !MEGA
    (void)hipFuncSetAttribute((const void*)k_one, hipFuncAttributeMaxDynamicSharedMemorySize, LDS_BYTES);
#endif
    configured = 1;
  }
#if MEGA
  (void)hipMemsetAsync(P.bar, 0, (size_t)XCD_BAR_WORDS * 4, stream);
  void* args[] = {&P};
  hipError_t e = hipLaunchCooperativeKernel((const void*)k_mega, dim3(256), dim3(NTHR), args, LDS_BYTES, stream);
  if (e != hipSuccess) fprintf(stderr, "cooperative launch failed: %s\n", hipGetErrorString(e));
#else
  for (int ph = 0; ph < NPHASES; ++ph) k_one<<<dim3(256), dim3(NTHR), LDS_BYTES, stream>>>(P, ph);
#endif
}
```
